# Optimizing an MI355X kernel written in HIP

```python
import math
import jax, jax.numpy as jnp
from jax import lax
import numpy as np

D_MODEL = 1024
BATCH = 4
SEQ = 8192
DEPTH = 2
DEC_BATCH = 8
DEC_SEQ = 32
PAST_LEN = 1024

CHUNK = 64
HEAD_DIM = 64
A_HEADS = 6
A_BACK_CHUNKS = 8
A_WIDTH = A_HEADS * HEAD_DIM
REL_CLIP = 128
B_GROUP_CH = 16
B_GROUPS = 16
B_WIDTH = B_GROUPS * B_GROUP_CH
B_STATE = 64
DT_MIN = 1e-3
DT_MAX = 1e-1
C_KV_HEADS = 2
C_GROUP = 3
C_WIDTH = C_KV_HEADS * C_GROUP * HEAD_DIM
C_KV_WIDTH = C_KV_HEADS * HEAD_DIM
C_WINDOW = 128
C_BACK_CHUNKS = C_WINDOW // CHUNK
ROPE_THETA = 500000.0
ROPE_DIM = HEAD_DIM // 4
D_MIX = A_WIDTH + B_WIDTH + C_WIDTH
D_IN = 3 * A_WIDTH + B_WIDTH + C_WIDTH + 2 * C_KV_WIDTH
SPLITS = (A_WIDTH, 2 * A_WIDTH, 3 * A_WIDTH, 3 * A_WIDTH + B_WIDTH,
          3 * A_WIDTH + B_WIDTH + C_WIDTH, 3 * A_WIDTH + B_WIDTH + C_WIDTH + C_KV_WIDTH)
D_FF = 2816
EPS = 1e-6
NEG_INF = -1e30
ATTN_SCALE = HEAD_DIM ** -0.5

kernel_name = "hybrid_streaming_encoder_step"


def rmsnorm(x, g):
    xf = x.astype(jnp.float32)
    y = xf * lax.rsqrt(jnp.mean(xf * xf, axis=-1, keepdims=True) + EPS)
    return (y * g.astype(jnp.float32)).astype(x.dtype)


def swiglu(x, w_up, w_down):
    gate, up = jnp.split(x @ w_up, 2, axis=-1)
    return (jax.nn.silu(gate) * up) @ w_down


def rope(x, pos):
    half = ROPE_DIM // 2
    inv_freq = ROPE_THETA ** (-jnp.arange(half, dtype=jnp.float32) / half)
    ang = pos.astype(jnp.float32)[:, None] * inv_freq[None, :]
    bshape = (pos.shape[0],) + (1,) * (x.ndim - 3) + (half,)
    cos = jnp.cos(ang).reshape(bshape)
    sin = jnp.sin(ang).reshape(bshape)
    xf = x.astype(jnp.float32)
    x1, x2, rest = xf[..., :half], xf[..., half:ROPE_DIM], xf[..., ROPE_DIM:]
    return jnp.concatenate([x1 * cos - x2 * sin, x2 * cos + x1 * sin, rest], axis=-1).astype(x.dtype)


def rel_bias(table, q_off, n_q, n_k):
    rel = q_off + jnp.arange(n_q)[:, None] - jnp.arange(n_k)[None, :]
    idx = jnp.clip(rel, -REL_CLIP, REL_CLIP) + REL_CLIP
    return table.astype(jnp.float32)[:, idx][:, None]


def band_softmax(q, k, v, bias, mask, sink):
    s = jnp.einsum('bnqhgd,bnkhd->bnhgqk', q, k, preferred_element_type=jnp.float32) * ATTN_SCALE
    s = jnp.where(mask, s + bias, NEG_INF)
    if sink is None:
        p = jax.nn.softmax(s, axis=-1)
    else:
        sk = sink.astype(jnp.float32)[None, None, :, :, None, None]
        m = jnp.maximum(jnp.max(s, axis=-1, keepdims=True), sk)
        e = jnp.exp(s - m)
        p = e / (jnp.sum(e, axis=-1, keepdims=True) + jnp.exp(sk - m))
    return jnp.einsum('bnhgqk,bnkhd->bnqhgd', p.astype(v.dtype), v)


def chunk_band(x, n_back):
    b, t, h, d = x.shape
    n = t // CHUNK
    xp = jnp.pad(x.reshape(b, n, CHUNK, h, d), ((0, 0), (n_back, 0), (0, 0), (0, 0), (0, 0)))
    return jnp.concatenate([xp[:, j:j + n] for j in range(n_back + 1)], axis=2)


def attend_prompt(q, k, v, n_back, table, sink):
    b, t = q.shape[0], q.shape[1]
    n = t // CHUNK
    kb, vb = chunk_band(k, n_back), chunk_band(v, n_back)
    n_k = kb.shape[2]
    qc = q.reshape((b, n, CHUNK) + q.shape[2:])
    kpos = jnp.arange(n)[:, None] * CHUNK + jnp.arange(n_k)[None, :] - n_back * CHUNK
    mask = (kpos >= 0)[None, :, None, None, None, :]
    bias = 0.0 if table is None else rel_bias(table, n_back * CHUNK, CHUNK, n_k)
    return band_softmax(qc, kb, vb, bias, mask, sink).reshape(b, t, -1)


def attend_sample(q, k, v, k_cache, v_cache, table, sink):
    b, t = q.shape[0], q.shape[1]
    w = k_cache.shape[1]
    kb = jnp.concatenate([k_cache.astype(k.dtype), k], axis=1)
    vb = jnp.concatenate([v_cache.astype(v.dtype), v], axis=1)
    bias = 0.0 if table is None else rel_bias(table, w, t, w + t)
    o = band_softmax(q[:, None], kb[:, None], vb[:, None], bias, True, sink)
    return o.reshape(b, t, -1), kb[:, -w:], vb[:, -w:]


def _ssm_combine(e1, e2):
    a1r, a1i, b1r, b1i = e1
    a2r, a2i, b2r, b2i = e2
    return (a2r * a1r - a2i * a1i, a2r * a1i + a2i * a1r,
            a2r * b1r - a2i * b1i + b2r, a2r * b1i + a2i * b1r + b2i)


def s5_scan(u, h0_re, h0_im, a_re, a_im, log_dt, b_re, b_im, c_re, c_im, d_skip):
    f32 = jnp.float32
    uf = u.astype(f32)
    ar, ai = a_re.astype(f32), a_im.astype(f32)
    dt = jnp.exp(log_dt.astype(f32))[:, None]
    mag = jnp.exp(ar * dt)
    lr, li = mag * jnp.cos(ai * dt), mag * jnp.sin(ai * dt)
    den = ar * ar + ai * ai
    zr = ((lr - 1.0) * ar + li * ai) / den
    zi = (li * ar - (lr - 1.0) * ai) / den
    br, bi = b_re.astype(f32), b_im.astype(f32)
    bbr = zr[..., None] * br - zi[..., None] * bi
    bbi = zr[..., None] * bi + zi[..., None] * br
    vr = jnp.einsum('btgh,gph->btgp', uf, bbr)
    vi = jnp.einsum('btgh,gph->btgp', uf, bbi)
    h0r, h0i = h0_re.astype(f32), h0_im.astype(f32)
    vr = vr.at[:, 0].add(lr * h0r - li * h0i)
    vi = vi.at[:, 0].add(lr * h0i + li * h0r)
    lam_r = jnp.broadcast_to(lr, vr.shape)
    lam_i = jnp.broadcast_to(li, vi.shape)
    _, _, xr, xi = lax.associative_scan(_ssm_combine, (lam_r, lam_i, vr, vi), axis=1)
    y = (jnp.einsum('btgp,ghp->btgh', xr, c_re.astype(f32))
         - jnp.einsum('btgp,ghp->btgh', xi, c_im.astype(f32))
         + d_skip.astype(f32) * uf)
    return y, xr[:, -1], xi[:, -1]


def trunk_layer(x, pos, cache, p):
    b, t, _ = x.shape
    g = p['norm_g']
    h = x + 0.5 * rmsnorm(swiglu(rmsnorm(x, g[0]), p['w_ffn_up'][0], p['w_ffn_down'][0]), g[1])
    hn = rmsnorm(h, g[2])
    qa, ka, va, ub, qc, kc, vc = jnp.split(hn @ p['w_in'], SPLITS, axis=-1)
    qa = qa.reshape(b, t, A_HEADS, 1, HEAD_DIM)
    ka = ka.reshape(b, t, A_HEADS, HEAD_DIM)
    va = va.reshape(b, t, A_HEADS, HEAD_DIM)
    qc = rope(qc.reshape(b, t, C_KV_HEADS, C_GROUP, HEAD_DIM), pos)
    kc = rope(kc.reshape(b, t, C_KV_HEADS, HEAD_DIM), pos)
    vc = vc.reshape(b, t, C_KV_HEADS, HEAD_DIM)
    ub = ub.reshape(b, t, B_GROUPS, B_GROUP_CH)
    if cache is None:
        oa = attend_prompt(qa, ka, va, A_BACK_CHUNKS, p['a_rel_bias'], None)
        oc = attend_prompt(qc, kc, vc, C_BACK_CHUNKS, None, p['c_sink'])
        wa = min(A_BACK_CHUNKS * CHUNK, t)
        wc = min(C_WINDOW, t)
        nak, nav = ka[:, t - wa:], va[:, t - wa:]
        nck, ncv = kc[:, t - wc:], vc[:, t - wc:]
        h0_re = jnp.zeros((b, B_GROUPS, B_STATE), jnp.float32)
        h0_im = jnp.zeros((b, B_GROUPS, B_STATE), jnp.float32)
    else:
        a_k, a_v, c_k, c_v, h0_re, h0_im = cache
        oa, nak, nav = attend_sample(qa, ka, va, a_k, a_v, p['a_rel_bias'], None)
        oc, nck, ncv = attend_sample(qc, kc, vc, c_k, c_v, None, p['c_sink'])
    y_ssm, s_re, s_im = s5_scan(ub, h0_re, h0_im, p['ssm_a_re'], p['ssm_a_im'], p['ssm_log_dt'],
                                p['ssm_b_re'], p['ssm_b_im'], p['ssm_c_re'], p['ssm_c_im'], p['ssm_d'])
    gl = jax.nn.gelu(y_ssm.reshape(b, t, B_WIDTH).astype(h.dtype))
    g1, g2 = jnp.split(gl @ p['w_glu'], 2, axis=-1)
    ob = g1 * jax.nn.sigmoid(g2)
    gb = p['branch_norm_g']
    mixed = jnp.concatenate([rmsnorm(oa, gb[:A_WIDTH]),
                             rmsnorm(ob, gb[A_WIDTH:A_WIDTH + B_WIDTH]),
                             rmsnorm(oc, gb[A_WIDTH + B_WIDTH:])], axis=-1)
    h = h + rmsnorm(mixed @ p['w_out'], g[3])
    h = h + 0.5 * rmsnorm(swiglu(rmsnorm(h, g[4]), p['w_ffn_up'][1], p['w_ffn_down'][1]), g[5])
    return h, (nak, nav, nck, ncv, s_re, s_im)


def setup_inputs(seed: int = 0) -> dict:
    key = jax.random.key(seed)
    ks = jax.random.split(key, 26)
    f32 = jnp.float32

    def nrm(k, shape, scale):
        return scale * jax.random.normal(k, shape, f32)

    wa = min(A_BACK_CHUNKS * CHUNK, PAST_LEN)
    wc = min(C_WINDOW, PAST_LEN)
    n_idx = jnp.arange(B_STATE, dtype=f32)
    return {
        'x_prompt': nrm(ks[0], (BATCH, SEQ, D_MODEL), 1.0),
        'x_sample': nrm(ks[1], (DEC_BATCH, DEC_SEQ, D_MODEL), 1.0),
        'cache_a_k': nrm(ks[2], (DEPTH, DEC_BATCH, wa, A_HEADS, HEAD_DIM), 1.0),
        'cache_a_v': nrm(ks[3], (DEPTH, DEC_BATCH, wa, A_HEADS, HEAD_DIM), 1.0),
        'cache_c_k': nrm(ks[4], (DEPTH, DEC_BATCH, wc, C_KV_HEADS, HEAD_DIM), 1.0),
        'cache_c_v': nrm(ks[5], (DEPTH, DEC_BATCH, wc, C_KV_HEADS, HEAD_DIM), 1.0),
        'state_ssm_re': nrm(ks[6], (DEPTH, DEC_BATCH, B_GROUPS, B_STATE), 0.5),
        'state_ssm_im': nrm(ks[7], (DEPTH, DEC_BATCH, B_GROUPS, B_STATE), 0.5),
        'norm_g': 1.0 + nrm(ks[8], (DEPTH, 6, D_MODEL), 0.05),
        'branch_norm_g': 1.0 + nrm(ks[9], (DEPTH, D_MIX), 0.05),
        'w_ffn_up': nrm(ks[10], (DEPTH, 2, D_MODEL, 2 * D_FF), D_MODEL ** -0.5),
        'w_ffn_down': nrm(ks[11], (DEPTH, 2, D_FF, D_MODEL), D_FF ** -0.5),
        'w_in': nrm(ks[12], (DEPTH, D_MODEL, D_IN), D_MODEL ** -0.5),
        'w_out': nrm(ks[13], (DEPTH, D_MIX, D_MODEL), D_MIX ** -0.5),
        'a_rel_bias': nrm(ks[14], (DEPTH, A_HEADS, 2 * REL_CLIP + 1), 0.5),
        'c_sink': nrm(ks[15], (DEPTH, C_KV_HEADS, C_GROUP), 1.0),
        'ssm_a_re': -0.5 + nrm(ks[16], (DEPTH, B_GROUPS, B_STATE), 0.01),
        'ssm_a_im': math.pi * n_idx + nrm(ks[17], (DEPTH, B_GROUPS, B_STATE), 0.01),
        'ssm_log_dt': jax.random.uniform(ks[18], (DEPTH, B_GROUPS), f32,
                                         minval=math.log(DT_MIN), maxval=math.log(DT_MAX)),
        'ssm_b_re': nrm(ks[19], (DEPTH, B_GROUPS, B_STATE, B_GROUP_CH), (2 * B_GROUP_CH) ** -0.5),
        'ssm_b_im': nrm(ks[20], (DEPTH, B_GROUPS, B_STATE, B_GROUP_CH), (2 * B_GROUP_CH) ** -0.5),
        'ssm_c_re': nrm(ks[21], (DEPTH, B_GROUPS, B_GROUP_CH, B_STATE), B_STATE ** -0.5),
        'ssm_c_im': nrm(ks[22], (DEPTH, B_GROUPS, B_GROUP_CH, B_STATE), B_STATE ** -0.5),
        'ssm_d': nrm(ks[23], (DEPTH, B_GROUPS, B_GROUP_CH), 1.0),
        'w_glu': nrm(ks[24], (DEPTH, B_WIDTH, 2 * B_WIDTH), B_WIDTH ** -0.5),
    }


def reference(x_prompt, x_sample, cache_a_k, cache_a_v, cache_c_k, cache_c_v, state_ssm_re, state_ssm_im,
              norm_g, branch_norm_g, w_ffn_up, w_ffn_down, w_in, w_out, a_rel_bias, c_sink,
              ssm_a_re, ssm_a_im, ssm_log_dt, ssm_b_re, ssm_b_im, ssm_c_re, ssm_c_im, ssm_d, w_glu):
    pos_p = jnp.arange(x_prompt.shape[1])
    pos_s = PAST_LEN + jnp.arange(x_sample.shape[1])
    yp, ys = x_prompt, x_sample
    st_p, st_s = [], []
    for l in range(DEPTH):
        p = {'norm_g': norm_g[l], 'branch_norm_g': branch_norm_g[l], 'w_ffn_up': w_ffn_up[l],
             'w_ffn_down': w_ffn_down[l], 'w_in': w_in[l], 'w_out': w_out[l], 'a_rel_bias': a_rel_bias[l],
             'c_sink': c_sink[l], 'ssm_a_re': ssm_a_re[l], 'ssm_a_im': ssm_a_im[l], 'ssm_log_dt': ssm_log_dt[l],
             'ssm_b_re': ssm_b_re[l], 'ssm_b_im': ssm_b_im[l], 'ssm_c_re': ssm_c_re[l], 'ssm_c_im': ssm_c_im[l],
             'ssm_d': ssm_d[l], 'w_glu': w_glu[l]}
        yp, sp = trunk_layer(yp, pos_p, None, p)
        ys, ss = trunk_layer(ys, pos_s, (cache_a_k[l], cache_a_v[l], cache_c_k[l], cache_c_v[l],
                                         state_ssm_re[l], state_ssm_im[l]), p)
        st_p.append(sp)
        st_s.append(ss)
    a_k_p = jnp.stack([s[0] for s in st_p])
    a_v_p = jnp.stack([s[1] for s in st_p])
    c_k_p = jnp.stack([s[2] for s in st_p])
    c_v_p = jnp.stack([s[3] for s in st_p])
    ssm_re_p = jnp.stack([s[4] for s in st_p])
    ssm_im_p = jnp.stack([s[5] for s in st_p])
    a_k_s = jnp.stack([s[0] for s in st_s])
    a_v_s = jnp.stack([s[1] for s in st_s])
    c_k_s = jnp.stack([s[2] for s in st_s])
    c_v_s = jnp.stack([s[3] for s in st_s])
    ssm_re_s = jnp.stack([s[4] for s in st_s])
    ssm_im_s = jnp.stack([s[5] for s in st_s])
    return (yp, ys, a_k_p, a_v_p, c_k_p, c_v_p, ssm_re_p, ssm_im_p,
            a_k_s, a_v_s, c_k_s, c_v_s, ssm_re_s, ssm_im_s)
```

```cpp
#include <hip/hip_runtime.h>
#include <hip/hip_cooperative_groups.h>
#include <cstdio>
#include <cstdint>
namespace cg = cooperative_groups;
namespace pg8 {
#define PG8_LAS __attribute__((address_space(3)))
typedef unsigned short bf16_t;
typedef short bf16x8 __attribute__((ext_vector_type(8)));
typedef float f32x4 __attribute__((ext_vector_type(4)));
typedef unsigned u32x4 __attribute__((ext_vector_type(4)));
constexpr int BM = 256, BK = 64, HALF = 128, HTB = HALF * BK * 2  , STAGE_BYTES = 8 * HTB, NXCD = 8, WGM = 8;

__host__ __device__ __forceinline__ int lds_byte(int r, int c) { const int st = (r >> 4) * 2 + (c >> 5), rr = r & 15, cc = c & 31, ob = rr * 64 + cc * 2; return st * 1024 + (ob ^ (((ob >> 9) & 1) << 5)); }
__host__ __device__ __forceinline__ void stage_rc(int b, int& R, int& C) { const int st = b / 1024, sb = b % 1024, swz = sb ^ (((sb >> 9) & 1) << 5); R = (st >> 1) * 16 + swz / 64; C = (st & 1) * 32 + (swz % 64) / 2; }
__host__ __device__ __forceinline__ int perm32(int rho) { const int n = rho >> 4, i = rho & 15; return 8 * (i >> 2) + 4 * n + (i & 3); }

struct Unit { int pm, pn; };
struct Gemm { const bf16_t* A; const bf16_t* Bt; int M, N, K; };

struct StaticOrder {
    int nM, nN, nwg, G, c;
    __host__ __device__ void init(int M, int N, int G_, int c_) { nM = M / BM; nN = N / BM; nwg = nM * nN; G = G_; c = c_; }
    __host__ __device__ bool next(int i, Unit& u) const {
        const long L = (long)i * G + c; if (L >= nwg) return false;
        int wgid = (int)L; { const int q = nwg / NXCD, r = nwg % NXCD, xcd = wgid % NXCD, off = wgid / NXCD; wgid = (xcd < r ? xcd * (q + 1) : r * (q + 1) + (xcd - r) * q) + off; }
        const int nig = WGM * nN, gid = wgid / nig, fm = gid * WGM, gsz = (nM - fm) < WGM ? (nM - fm) : WGM;
        u.pm = fm + ((wgid % nig) % gsz); u.pn = (wgid % nig) / gsz; return true;
    }
    __device__ __forceinline__ void a_ready(const Unit&) const {}
    __device__ __forceinline__ void done(const Unit&) const {}
};
__device__ __forceinline__ unsigned cvt_pk_bf16(float lo, float hi) { unsigned r; asm volatile("v_cvt_pk_bf16_f32 %0, %1, %2" : "=v"(r) : "v"(lo), "v"(hi)); return r; }

typedef float f32x2 __attribute__((ext_vector_type(2)));
__device__ __forceinline__ float fast_sigmoid(float x) { return __builtin_amdgcn_rcpf(1.0f + __builtin_amdgcn_exp2f(-1.4426950408889634f * x)); }

struct EpiOut {
    static constexpr bool PERM = true, AFTER_DRAIN = false;
    bf16_t* O; int ldc;
    __device__ __forceinline__ void operator()(const f32x4 (&acc)[2][2][4][2], const Unit& u, int wr, int wc, int fr, int fq) const {
        const int row0 = u.pm * BM + wr * 64 + fr, col0 = u.pn * BM + wc * 32 + 8 * fq;
#pragma unroll
        for (int ai = 0; ai < 2; ++ai)
#pragma unroll
            for (int m = 0; m < 4; ++m) { bf16_t* rowp = O + (size_t)(row0 + ai * HALF + m * 16) * ldc + col0;
#pragma unroll
                for (int bj = 0; bj < 2; ++bj) { const f32x4 v0 = acc[ai][bj][m][0], v1 = acc[ai][bj][m][1];
                    u32x4 w; w.x = cvt_pk_bf16(v0[0], v0[1]); w.y = cvt_pk_bf16(v0[2], v0[3]); w.z = cvt_pk_bf16(v1[0], v1[1]); w.w = cvt_pk_bf16(v1[2], v1[3]);
                    *(u32x4*)(rowp + bj * HALF) = w; } }
    }
};

template <int MODE> struct EpiGlu {
    static constexpr bool PERM = true, AFTER_DRAIN = false;
    bf16_t* O; int ldc;
    __device__ __forceinline__ void operator()(const f32x4 (&acc)[2][2][4][2], const Unit& u, int wr, int wc, int fr, int fq) const {
        const int row0 = u.pm * BM + wr * 64 + fr, col0 = u.pn * HALF + wc * 32 + 8 * fq;
#pragma unroll
        for (int ai = 0; ai < 2; ++ai)
#pragma unroll
            for (int m = 0; m < 4; ++m) { const int row = row0 + ai * HALF + m * 16;
                float o[8];
#pragma unroll
                for (int n = 0; n < 2; ++n)
#pragma unroll
                    for (int j = 0; j < 4; ++j) { const float a = acc[ai][0][m][n][j], b = acc[ai][1][m][n][j];
                        o[4 * n + j] = (MODE == 0) ? a * fast_sigmoid(a) * b : a * fast_sigmoid(b); }
                u32x4 w; w.x = cvt_pk_bf16(o[0], o[1]); w.y = cvt_pk_bf16(o[2], o[3]); w.z = cvt_pk_bf16(o[4], o[5]); w.w = cvt_pk_bf16(o[6], o[7]);
                *(u32x4*)(O + (size_t)row * ldc + col0) = w;
            }
    }
};

struct EpiQKV {
    static constexpr bool PERM = true, AFTER_DRAIN = false;
    bf16_t* Q; const f32x2* rope; float* out; int l;
    __device__ __forceinline__ void operator()(const f32x4 (&acc)[2][2][4][2], const Unit& u, int wr, int wc, int fr, int fq) const {
        const float QS = 0.125f * 1.4426950408889634f;
        const bool samp = u.pm >= 128;
        const int oak = samp ? 37240832 + l * 1572864 : 33816576 + l * 786432;
        const int oav = samp ? 40386560 + l * 1572864 : 35389440 + l * 786432;
        const int ock = samp ? 43532288 + l * 131072 : 36962304 + l * 65536;
        const int ocv = samp ? 43794432 + l * 131072 : 37093376 + l * 65536;
#pragma unroll
        for (int ai = 0; ai < 2; ++ai)
#pragma unroll
            for (int m = 0; m < 4; ++m) {
                const int r = u.pm * BM + ai * HALF + wr * 64 + m * 16 + fr;
                int b, t, qrow, pos, arow, crow;
                if (!samp) { b = r >> 13; t = r & 8191; qrow = r; pos = t; arow = (t >= 7680) ? b * 512 + t - 7680 : -1; crow = (t >= 8064) ? b * 128 + t - 8064 : -1; }
                else { const int s = r - 32768; b = s >> 5; t = s & 31; qrow = 32768 + b * 544 + 512 + t; pos = 1024 + t; arow = b * 512 + 480 + t; crow = b * 128 + 96 + t; }
#pragma unroll
                for (int bj = 0; bj < 2; ++bj) {
                    const int cb = 2 * u.pn + bj, gcol = cb * 128 + wc * 32;
                    f32x4 pa = acc[ai][bj][m][0], pb = acc[ai][bj][m][1]; int ca_ = gcol + 8 * fq, cb_ = ca_ + 4;
                    if (cb >= 11 && cb <= 14 && (wc & 1) == 0 && fq < 2) {
                        const f32x4* rp = (const f32x4*)(rope + (size_t)pos * 8) + 2 * fq; const f32x4 t0 = rp[0], t1 = rp[1];
                        const f32x4 x1 = (f32x4){pa[0], pa[2], pb[0], pb[2]}, x2 = (f32x4){pa[1], pa[3], pb[1], pb[3]};
                        const f32x4 cs = (f32x4){t0[0], t0[2], t1[0], t1[2]}, sn = (f32x4){t0[1], t0[3], t1[1], t1[3]};
                        pa = x1 * cs - x2 * sn; pb = x2 * cs + x1 * sn; ca_ = gcol + 4 * fq; cb_ = gcol + 8 + 4 * fq; }
                    int dbase = -1;
                    if (cb >= 3 && cb <= 5) { if (arow >= 0) dbase = oak + arow * 384 - 384; }
                    else if (cb >= 6 && cb <= 8) { if (arow >= 0) dbase = oav + arow * 384 - 768; }
                    else if (cb == 14) { if (crow >= 0) dbase = ock + crow * 128 - 1792; }
                    else if (cb == 15) { if (crow >= 0) dbase = ocv + crow * 128 - 1920; }
                    if (dbase >= 0) { *(f32x4*)(out + (dbase + ca_)) = pa; *(f32x4*)(out + (dbase + cb_)) = pb; }
                    if (cb < 3 || (cb >= 11 && cb <= 13)) { pa = pa * QS; pb = pb * QS; }
                    typedef unsigned u32x2 __attribute__((ext_vector_type(2)));
                    u32x2 wa, wb; wa.x = cvt_pk_bf16(pa[0], pa[1]); wa.y = cvt_pk_bf16(pa[2], pa[3]); wb.x = cvt_pk_bf16(pb[0], pb[1]); wb.y = cvt_pk_bf16(pb[2], pb[3]);
                    *(u32x2*)(Q + (size_t)qrow * 2048 + ca_) = wa; *(u32x2*)(Q + (size_t)qrow * 2048 + cb_) = wb;
                }
            }
    }
};
template <class Epi, class Sched, bool ALIGN_EPI = false, bool SP2 = false>
__device__ __forceinline__ void gemm_phase(PG8_LAS unsigned char* lds, const Gemm g, const Sched& S, const Epi& E, int tid_in) {
    int tid_ = tid_in; asm volatile("" : "+v"(tid_));
    const int tid = tid_, wid = __builtin_amdgcn_readfirstlane(tid >> 6), lane = tid & 63, wr = wid >> 2, wc = wid & 3, fr = lane & 15, fq = lane >> 4;
    const int K = g.K, nt = K / BK;
    unsigned voffA[2], voffB[2];
#pragma unroll
    for (int i = 0; i < 2; ++i) { int R, C; stage_rc(tid * 16 + i * 8192, R, C); const int Rb = Epi::PERM ? ((R & ~31) + perm32(R & 31)) : R;
        voffA[i] = (unsigned)(R * K + C) * 2u; voffB[i] = (unsigned)(Rb * K + C) * 2u; }
    const size_t kstep = (size_t)(BK * 2);
    const size_t hstep = (size_t)HALF * K * 2;
    const size_t tstep = 2 * hstep;
    const unsigned ldsw = (unsigned)wid * 1024u;
    const int aoff = lds_byte(wr * 64 + fr, fq * 8), boff = lds_byte(wc * 32 + fr, fq * 8);
#define PG8_SA(b, h) (((b) * 2 + (h)) * HTB)
#define PG8_SB(b, h) ((4 + (b) * 2 + (h)) * HTB)
#define PG8_STAGE(bufoff, gbase, voff) do { _Pragma("unroll") for (int _i = 0; _i < 2; ++_i) \
        __builtin_amdgcn_global_load_lds((const unsigned*)((const char*)(gbase) + (voff)[_i]), (PG8_LAS unsigned*)(lds + (bufoff) + ldsw + _i * 8192), 16, 0, 0); } while (0)
#define PG8_LDA(dst, b, h) do { _Pragma("unroll") for (int m = 0; m < 4; ++m) _Pragma("unroll") for (int k = 0; k < 2; ++k) dst[m][k] = *(const PG8_LAS bf16x8*)(lds + PG8_SA(b, h) + aoff + m * 2048 + k * 1024); } while (0)
#define PG8_LDB(dst, b, h) do { _Pragma("unroll") for (int n = 0; n < 2; ++n) _Pragma("unroll") for (int k = 0; k < 2; ++k) dst[n][k] = *(const PG8_LAS bf16x8*)(lds + PG8_SB(b, h) + boff + n * 2048 + k * 1024); } while (0)
#define PG8_MMA(ai, bj, At, Bt) do { __builtin_amdgcn_s_setprio(1); _Pragma("unroll") for (int m = 0; m < 4; ++m) _Pragma("unroll") for (int n = 0; n < 2; ++n) _Pragma("unroll") for (int k = 0; k < 2; ++k) \
        acc[ai][bj][m][n] = __builtin_amdgcn_mfma_f32_16x16x32_bf16(Bt[n][k], At[m][k], acc[ai][bj][m][n], 0, 0, 0); __builtin_amdgcn_s_setprio(0); } while (0)
#define PG8_WAIT_V(n) asm volatile("s_waitcnt vmcnt(" #n ")" ::: "memory")
#define PG8_WAIT_L(n) asm volatile("s_waitcnt lgkmcnt(" #n ")" ::: "memory")
#define PG8_BAR __builtin_amdgcn_s_barrier()
#define PG8_SCHED __builtin_amdgcn_sched_barrier(0)
    Unit cur, nxt; int ui = 0;
    if (!S.next(0, cur)) return;
    f32x4 acc[2][2][4][2];
#pragma unroll
    for (int a = 0; a < 2; ++a)
#pragma unroll
        for (int b = 0; b < 2; ++b)
#pragma unroll
            for (int m = 0; m < 4; ++m)
#pragma unroll
                for (int n = 0; n < 2; ++n) acc[a][b][m][n] = (f32x4){0.f, 0.f, 0.f, 0.f};
    bf16x8 At[4][2], B0[2][2], B1[2][2];
    const char* cA = (const char*)g.A + (size_t)cur.pm * tstep; const char* cB = (const char*)g.Bt + (size_t)cur.pn * tstep;
    S.a_ready(cur);
    if constexpr (SP2) {
        PG8_STAGE(PG8_SB(0, 0), cB, voffB); PG8_STAGE(PG8_SB(0, 1), cB + hstep, voffB); PG8_STAGE(PG8_SA(0, 0), cA, voffA); PG8_STAGE(PG8_SA(0, 1), cA + hstep, voffA);
        if (wr == 1) PG8_BAR;
        PG8_WAIT_V(2); PG8_BAR;
        PG8_STAGE(PG8_SB(1, 0), cB + kstep, voffB); PG8_STAGE(PG8_SA(1, 0), cA + kstep, voffA); PG8_STAGE(PG8_SB(1, 1), cB + hstep + kstep, voffB);
        PG8_WAIT_V(6); PG8_BAR;
    } else {
        PG8_STAGE(PG8_SB(0, 0), cB, voffB); PG8_STAGE(PG8_SA(0, 0), cA, voffA); PG8_STAGE(PG8_SB(0, 1), cB + hstep, voffB); PG8_STAGE(PG8_SA(0, 1), cA + hstep, voffA);
        if (wr == 1) PG8_BAR;
        PG8_WAIT_V(4); PG8_BAR;
        PG8_STAGE(PG8_SB(1, 0), cB + kstep, voffB); PG8_STAGE(PG8_SA(1, 0), cA + kstep, voffA); PG8_STAGE(PG8_SB(1, 1), cB + hstep + kstep, voffB);
        PG8_WAIT_V(6); PG8_BAR;
    }
    for (;;) {
        const bool has_next = S.next(ui + 1, nxt);
        const char* nA = has_next ? (const char*)g.A + (size_t)nxt.pm * tstep : cA; const char* nB = has_next ? (const char*)g.Bt + (size_t)nxt.pn * tstep : cB;
        for (int t = 0; t < nt; t += 2) {
            const bool last = (t == nt - 2);
            const char* a1 = cA + (size_t)(t + 1) * kstep;
            const char* a2 = last ? nA : cA + (size_t)(t + 2) * kstep; const char* b2 = last ? nB : cB + (size_t)(t + 2) * kstep;
            const char* a3 = a2 + kstep; const char* b3 = b2 + kstep;
            if (last && has_next) S.a_ready(nxt);
            if constexpr (SP2) {
            PG8_LDB(B0, 0, 0); PG8_LDB(B1, 0, 1); PG8_SCHED; PG8_LDA(At, 0, 0); PG8_STAGE(PG8_SA(1, 1), a1 + hstep, voffA);
            PG8_WAIT_V(8); PG8_WAIT_L(0); PG8_BAR; PG8_MMA(0, 0, At, B0); PG8_MMA(0, 1, At, B1); PG8_BAR; PG8_SCHED;
            PG8_LDA(At, 0, 1); PG8_STAGE(PG8_SB(0, 0), b2, voffB); PG8_STAGE(PG8_SB(0, 1), b2 + hstep, voffB); PG8_STAGE(PG8_SA(0, 0), a2, voffA);
            PG8_WAIT_V(8); PG8_WAIT_L(0); PG8_BAR; PG8_MMA(1, 0, At, B0); PG8_MMA(1, 1, At, B1); PG8_BAR; PG8_SCHED;
            PG8_LDB(B0, 1, 0); PG8_LDB(B1, 1, 1); PG8_SCHED; PG8_LDA(At, 1, 0); PG8_STAGE(PG8_SA(0, 1), a2 + hstep, voffA);
            PG8_WAIT_V(8); PG8_WAIT_L(0); PG8_BAR; PG8_MMA(0, 0, At, B0); PG8_MMA(0, 1, At, B1); PG8_BAR; PG8_SCHED;
            PG8_LDA(At, 1, 1); PG8_STAGE(PG8_SB(1, 0), b3, voffB); PG8_STAGE(PG8_SB(1, 1), b3 + hstep, voffB); PG8_STAGE(PG8_SA(1, 0), a3, voffA);
            PG8_WAIT_V(8); PG8_WAIT_L(0); PG8_BAR; PG8_MMA(1, 0, At, B0); PG8_MMA(1, 1, At, B1); PG8_BAR; PG8_SCHED;
            } else {
            PG8_LDB(B0, 0, 0); PG8_SCHED; PG8_LDA(At, 0, 0); PG8_STAGE(PG8_SA(1, 1), a1 + hstep, voffA);
            PG8_WAIT_L(8); PG8_BAR; PG8_WAIT_L(0); PG8_MMA(0, 0, At, B0); PG8_BAR; PG8_SCHED;
            PG8_LDB(B1, 0, 1); PG8_STAGE(PG8_SB(0, 0), b2, voffB);
            PG8_BAR; PG8_WAIT_L(0); PG8_MMA(0, 1, At, B1); PG8_BAR;
            PG8_LDA(At, 0, 1); PG8_STAGE(PG8_SA(0, 0), a2, voffA);
            PG8_BAR; PG8_WAIT_L(0); PG8_MMA(1, 0, At, B0); PG8_BAR; PG8_SCHED;
            PG8_STAGE(PG8_SB(0, 1), b2 + hstep, voffB);
            PG8_WAIT_V(6); PG8_BAR; PG8_MMA(1, 1, At, B1); PG8_BAR;
            PG8_LDB(B0, 1, 0); PG8_SCHED; PG8_LDA(At, 1, 0); PG8_STAGE(PG8_SA(0, 1), a2 + hstep, voffA);
            PG8_WAIT_L(8); PG8_BAR; PG8_WAIT_L(0); PG8_MMA(0, 0, At, B0); PG8_BAR; PG8_SCHED;
            PG8_LDB(B1, 1, 1); PG8_STAGE(PG8_SB(1, 0), b3, voffB);
            PG8_BAR; PG8_WAIT_L(0); PG8_MMA(0, 1, At, B1); PG8_BAR;
            PG8_LDA(At, 1, 1); PG8_STAGE(PG8_SA(1, 0), a3, voffA);
            PG8_BAR; PG8_WAIT_L(0); PG8_MMA(1, 0, At, B0); PG8_BAR; PG8_SCHED;
            PG8_STAGE(PG8_SB(1, 1), b3 + hstep, voffB);
            PG8_WAIT_V(6); PG8_BAR; PG8_MMA(1, 1, At, B1); PG8_BAR;
            }
        }
        if constexpr (ALIGN_EPI) { if (wr == 0) PG8_BAR; }
        if constexpr (!Epi::AFTER_DRAIN) { E(acc, cur, wr, wc, fr, fq); S.done(cur); }
        if (!has_next) break;
#pragma unroll
        for (int a = 0; a < 2; ++a)
#pragma unroll
            for (int b = 0; b < 2; ++b)
#pragma unroll
                for (int m = 0; m < 4; ++m)
#pragma unroll
                    for (int n = 0; n < 2; ++n) acc[a][b][m][n] = (f32x4){0.f, 0.f, 0.f, 0.f};
        cur = nxt; cA = nA; cB = nB; ++ui;
        if constexpr (ALIGN_EPI) { if (wr == 1) PG8_BAR; }
    }
    PG8_WAIT_V(0);
    if constexpr (!ALIGN_EPI) { if (wr == 0) PG8_BAR; }
    PG8_BAR;
    if constexpr (Epi::AFTER_DRAIN) { E.fused(acc, cur, wr, wc, fr, fq, lds, wid, lane); S.done(cur); }
#undef PG8_SA
#undef PG8_SB
#undef PG8_STAGE
#undef PG8_LDA
#undef PG8_LDB
#undef PG8_MMA
#undef PG8_WAIT_V
#undef PG8_WAIT_L
#undef PG8_BAR
#undef PG8_SCHED
}
}

#ifndef PHMASK
#define PHMASK 0xffffffffu
#endif
constexpr unsigned PHM = PHMASK;
constexpr int NWAVES = 8, NTHREADS = 512;
constexpr int DM = 1024, TP = 32768, TS = 256, TT = TP + TS;
constexpr int DFF = 2816, DIN = 2048;
constexpr int QROWS = TP + 8 * 544;
constexpr float EPSN = 1e-6f, LOG2E = 1.4426950408889634f;
constexpr size_t O_YP = 0, O_YS = 33554432, O_AKP = 33816576, O_AVP = 35389440, O_CKP = 36962304, O_CVP = 37093376, O_SRP = 37224448, O_SIP = 37232640,
                 O_AKS = 37240832, O_AVS = 40386560, O_CKS = 43532288, O_CVS = 43794432, O_SRS = 44056576, O_SIS = 44072960;
constexpr size_t MiB = 1u << 20;
constexpr size_t WS_ROPE = 0, WS_LAM = 1 * MiB, WS_L64 = WS_LAM + 32768, WS_BBR = WS_L64 + 32768, WS_BBI = WS_BBR + 262144, WS_CCB = WS_BBI + 262144;
constexpr size_t WS_SSH = 2 * MiB, WS_SLOC = 5 * MiB;
constexpr size_t WS_WUP = 10 * MiB, WS_WDN = 54 * MiB, WS_WIN = 76 * MiB, WS_WOUT = 84 * MiB, WS_WGLU = 88 * MiB;
constexpr size_t WS_XN = 89 * MiB, WS_OUT = 154 * MiB, WS_MIX = 219 * MiB, WS_YB = 284 * MiB, WS_ACT = 301 * MiB, WS_QKV = WS_ACT, WS_END = 480 * MiB;
static_assert(WS_CCB + 131072 <= WS_SSH && WS_SSH + (size_t)TT * 16 * 4 <= WS_SLOC && WS_SLOC + 4 * MiB <= WS_WUP, "ws small region");
static_assert(WS_ACT + (size_t)TT * DFF * 2 <= WS_END && WS_QKV + (size_t)(QROWS + 64) * DIN * 2 <= WS_END, "ws big region");
constexpr int LDS_BYTES = 147456, WAVE_LDS = 9216, TAB_OFF = NWAVES * WAVE_LDS;

#define GAS __attribute__((address_space(1)))
#define LAS __attribute__((address_space(3)))
typedef unsigned short bf16;
typedef unsigned v4u __attribute__((ext_vector_type(4)));
typedef unsigned v2u __attribute__((ext_vector_type(2)));
typedef float f32x4 __attribute__((ext_vector_type(4)));
typedef float f32x2 __attribute__((ext_vector_type(2)));
typedef short bf16x8 __attribute__((ext_vector_type(8)));
typedef short s16x4 __attribute__((ext_vector_type(4)));
typedef short v4i16_t __attribute__((ext_vector_type(4)));
#define LDS_WAIT() asm volatile("s_waitcnt lgkmcnt(0)" ::: "memory")
#define CFENCE() asm volatile("" ::: "memory")
__device__ __forceinline__ unsigned f2bf(float f) { unsigned u = __builtin_bit_cast(unsigned, f); return (u + 0x7fffu + ((u >> 16) & 1u)) >> 16; }
__device__ __forceinline__ unsigned pk2(float lo, float hi) { return f2bf(lo) | (f2bf(hi) << 16); }
__device__ __forceinline__ float bflo(unsigned w) { return __builtin_bit_cast(float, w << 16); }
__device__ __forceinline__ float bfhi(unsigned w) { return __builtin_bit_cast(float, w & 0xffff0000u); }
__device__ __forceinline__ float shx(float v, int mask, int lane) { return __builtin_bit_cast(float, __builtin_amdgcn_ds_bpermute((lane ^ mask) << 2, __builtin_bit_cast(int, v))); }
__device__ __forceinline__ float wave_sum(float v, int lane) {
#pragma unroll
    for (int o = 1; o < 64; o <<= 1) v += shx(v, o, lane);
    return v;
}
__device__ __forceinline__ s16x4 vtr(const LAS unsigned char* p) { return __builtin_bit_cast(s16x4, __builtin_amdgcn_ds_read_tr16_b64_v4i16((LAS v4i16_t*)p)); }

struct Args { const float* in[25]; float* out; unsigned char* ws; int ph_lo, ph_hi, li, pad; };
__device__ __forceinline__ int lane_id_v() { int r; asm volatile("v_mbcnt_lo_u32_b32 %0, -1, 0\n\tv_mbcnt_hi_u32_b32 %0, -1, %0" : "=v"(r)); return r; }
constexpr size_t WS_CTL = 9 * MiB;
__device__ __forceinline__ void gbar(unsigned* ctr, unsigned target, int tid) {
    asm volatile("s_waitcnt vmcnt(0) lgkmcnt(0)" ::: "memory");
    __syncthreads();
    if (tid == 0) {
        __builtin_amdgcn_fence(__ATOMIC_RELEASE, "agent");
        asm volatile("s_waitcnt vmcnt(0)" ::: "memory");
        __hip_atomic_fetch_add(ctr, 1u, __ATOMIC_RELAXED, __HIP_MEMORY_SCOPE_AGENT);
        while (__hip_atomic_load(ctr, __ATOMIC_RELAXED, __HIP_MEMORY_SCOPE_AGENT) < target) __builtin_amdgcn_s_sleep(2);
        __builtin_amdgcn_fence(__ATOMIC_ACQUIRE, "agent");
        asm volatile("s_waitcnt vmcnt(0)" ::: "memory");
    }
    __syncthreads();
}
constexpr int PTAB_OFF = LDS_BYTES - 512;
__device__ __forceinline__ const float* inptr(LAS unsigned char* lds, int k) { const LAS unsigned* t = (const LAS unsigned*)(lds + PTAB_OFF) + 2 * k;
    const unsigned lo = __builtin_amdgcn_readfirstlane(t[0]), hi = __builtin_amdgcn_readfirstlane(t[1]); return (const float*)(((unsigned long long)hi << 32) | lo); }

__device__ __forceinline__ void transpose_item(const float* __restrict__ W, int K, int N, bf16* WT, int dst_row0, int k0, int n0, const float* kscale, LAS float* scr, int lane, bool ropeperm = false) {
#pragma unroll 8
    for (int i = 0; i < 32; ++i) { const int kk = 2 * i + (lane >> 5); float v = W[(size_t)(k0 + kk) * N + n0 + (lane & 31)]; if (kscale) v *= kscale[k0 + kk]; scr[kk * 33 + (lane & 31)] = v; }
    LDS_WAIT();
    const int c = lane & 7;
#pragma unroll
    for (int j = 0; j < 4; ++j) { const int n = (lane >> 3) + 8 * j; const LAS float* s = scr + (8 * c) * 33 + n;
        const int nd = (ropeperm && n < 16) ? (8 * ((n >> 2) & 1) + 2 * (n & 3) + ((n >> 3) & 1)) : n;
        v4u o; o.x = pk2(s[0 * 33], s[1 * 33]); o.y = pk2(s[2 * 33], s[3 * 33]); o.z = pk2(s[4 * 33], s[5 * 33]); o.w = pk2(s[6 * 33], s[7 * 33]);
        *(v4u*)(WT + (size_t)(dst_row0 + nd) * K + k0 + 8 * c) = o; }
    LDS_WAIT();
}
__device__ __forceinline__ int glu_row(int n0, int half) { const int j = (n0 < half) ? n0 : n0 - half; return (j >> 7) * 256 + (j & 127) + ((n0 < half) ? 0 : 128); }

__device__ __forceinline__ void row_pass(const float* xin, float* X, const bf16* OUT, const float* ga, float scale, bf16* XN, const float* gb, int lane) {
    f32x4 v[4];
#pragma unroll
    for (int j = 0; j < 4; ++j) v[j] = ((const f32x4*)xin)[lane + 64 * j];
    if (OUT) {
        f32x4 o[4]; float s = 0.f;
#pragma unroll
        for (int j = 0; j < 4; ++j) { const v2u w = ((const v2u*)OUT)[lane + 64 * j]; o[j] = (f32x4){bflo(w.x), bfhi(w.x), bflo(w.y), bfhi(w.y)}; s += (o[j].x * o[j].x + o[j].y * o[j].y) + (o[j].z * o[j].z + o[j].w * o[j].w); }
        const float rs = scale * __builtin_amdgcn_rsqf(wave_sum(s, lane) * (1.f / DM) + EPSN);
#pragma unroll
        for (int j = 0; j < 4; ++j) { const f32x4 g = ((const f32x4*)ga)[lane + 64 * j]; v[j] = v[j] + o[j] * g * rs; }
    }
#pragma unroll
    for (int j = 0; j < 4; ++j) ((f32x4*)X)[lane + 64 * j] = v[j];
    if (gb) {
        float s = 0.f;
#pragma unroll
        for (int j = 0; j < 4; ++j) s += (v[j].x * v[j].x + v[j].y * v[j].y) + (v[j].z * v[j].z + v[j].w * v[j].w);
        const float rs = __builtin_amdgcn_rsqf(wave_sum(s, lane) * (1.f / DM) + EPSN);
#pragma unroll
        for (int j = 0; j < 4; ++j) { const f32x4 g = ((const f32x4*)gb)[lane + 64 * j]; const f32x4 y = v[j] * g * rs; v2u w; w.x = pk2(y.x, y.y); w.y = pk2(y.z, y.w); ((v2u*)XN)[lane + 64 * j] = w; }
    }
}

template <int NQB> __device__ __forceinline__ void attn_unit(const bf16* __restrict__ QKV, bf16* MIX, float* SSH, LAS unsigned char* wl, const LAS float* tab, bool has_bias,
                                          int srow0, int qpos0, int kt0, int kend, int qcol, int kcol, int vcol, int ocol, int sidx, int mixrow0, float m_init, bool has_sink, int lane) {
    const int fr = lane & 15, fq = lane >> 4; constexpr int nqb = NQB, nq = 16 * NQB;
    bf16x8 qf[NQB][2];
#pragma unroll
    for (int qb = 0; qb < NQB; ++qb) { int qr = 16 * qb + fr; qr = qr < nq ? qr : nq - 1; const bf16* qp = QKV + (size_t)(srow0 + qpos0 + qr) * DIN + qcol + 8 * fq;
        qf[qb][0] = *(const bf16x8*)qp; qf[qb][1] = *(const bf16x8*)(qp + 32); }
    f32x4 o[NQB][4]; float mrun[NQB], lrun[NQB];
#pragma unroll
    for (int qb = 0; qb < NQB; ++qb) { mrun[qb] = m_init; lrun[qb] = (has_sink && fq == 0) ? 1.f : 0.f;
#pragma unroll
        for (int db = 0; db < 4; ++db) o[qb][db] = (f32x4){0.f, 0.f, 0.f, 0.f}; }
    for (int kt = kt0; kt < kend; kt += 64) {
        bf16x8 kf[4][2];
#pragma unroll
        for (int kb = 0; kb < 4; ++kb) { int kr = kt + 16 * kb + fr; kr = kr < kend ? kr : kend - 1; const bf16* kp = QKV + (size_t)(srow0 + kr) * DIN + kcol + 8 * fq;
            kf[kb][0] = *(const bf16x8*)kp; kf[kb][1] = *(const bf16x8*)(kp + 32); }
        CFENCE();
#pragma unroll
        for (int i = 0; i < 8; ++i) { const int key = 8 * i + (lane >> 3); int kr = kt + key; kr = kr < kend ? kr : kend - 1;
            const v4u v = *(const v4u*)(QKV + (size_t)(srow0 + kr) * DIN + vcol + 8 * (lane & 7)); *(LAS v4u*)(wl + key * 144 + (lane & 7) * 16) = v; }
        CFENCE();
        const bool tail = (kt + 64 > kend), far = (qpos0 - kt - 63 >= 128);
        bf16x8 pf[NQB][2];
#pragma unroll
        for (int qb = 0; qb < NQB; ++qb) if (qb < nqb) {
            f32x4 s[4];
#pragma unroll
            for (int kb = 0; kb < 4; ++kb) { s[kb] = (f32x4){0.f, 0.f, 0.f, 0.f};
                s[kb] = __builtin_amdgcn_mfma_f32_16x16x32_bf16(kf[kb][0], qf[qb][0], s[kb], 0, 0, 0);
                s[kb] = __builtin_amdgcn_mfma_f32_16x16x32_bf16(kf[kb][1], qf[qb][1], s[kb], 0, 0, 0); }
            if (has_bias) {
                if (far) { const float bc = tab[256];
#pragma unroll
                    for (int kb = 0; kb < 4; ++kb) s[kb] = s[kb] + bc; }
                else { const int rel0 = qpos0 + 16 * qb + fr - kt - 4 * fq;
#pragma unroll
                    for (int kb = 0; kb < 4; ++kb)
#pragma unroll
                        for (int j = 0; j < 4; ++j) { int rel = rel0 - 16 * kb - j; rel = rel < -128 ? -128 : (rel > 128 ? 128 : rel); s[kb][j] += tab[rel + 128]; } }
            }
            if (tail) {
#pragma unroll
                for (int kb = 0; kb < 4; ++kb)
#pragma unroll
                    for (int j = 0; j < 4; ++j) if (kt + 16 * kb + 4 * fq + j >= kend) s[kb][j] = -1e30f;
            }
            float mx = fmaxf(fmaxf(fmaxf(s[0][0], s[0][1]), fmaxf(s[0][2], s[0][3])), fmaxf(fmaxf(s[1][0], s[1][1]), fmaxf(s[1][2], s[1][3])));
            mx = fmaxf(mx, fmaxf(fmaxf(fmaxf(s[2][0], s[2][1]), fmaxf(s[2][2], s[2][3])), fmaxf(fmaxf(s[3][0], s[3][1]), fmaxf(s[3][2], s[3][3]))));
            mx = fmaxf(mx, shx(mx, 16, lane)); mx = fmaxf(mx, shx(mx, 32, lane));
            const float mnew = fmaxf(mrun[qb], mx), alpha = __builtin_amdgcn_exp2f(mrun[qb] - mnew); mrun[qb] = mnew;
            float ps = 0.f;
#pragma unroll
            for (int kb = 0; kb < 4; ++kb)
#pragma unroll
                for (int j = 0; j < 4; ++j) { const float p = __builtin_amdgcn_exp2f(s[kb][j] - mnew); s[kb][j] = p; ps += p; }
            lrun[qb] = lrun[qb] * alpha + ps;
#pragma unroll
            for (int db = 0; db < 4; ++db) o[qb][db] = o[qb][db] * alpha;
#pragma unroll
            for (int kh = 0; kh < 2; ++kh) { v4u w; w.x = pk2(s[2 * kh][0], s[2 * kh][1]); w.y = pk2(s[2 * kh][2], s[2 * kh][3]); w.z = pk2(s[2 * kh + 1][0], s[2 * kh + 1][1]); w.w = pk2(s[2 * kh + 1][2], s[2 * kh + 1][3]);
                pf[qb][kh] = __builtin_bit_cast(bf16x8, w); }
        }
#pragma unroll
        for (int kh = 0; kh < 2; ++kh)
#pragma unroll
            for (int db = 0; db < 4; ++db) {
                const LAS unsigned char* vp = wl + (32 * kh + 4 * fq + (fr >> 2)) * 144 + 32 * db + 8 * (fr & 3);
                const s16x4 lo = vtr(vp), hi = vtr(vp + 16 * 144);
                const bf16x8 vf = (bf16x8){lo[0], lo[1], lo[2], lo[3], hi[0], hi[1], hi[2], hi[3]};
#pragma unroll
                for (int qb = 0; qb < NQB; ++qb) if (qb < nqb) o[qb][db] = __builtin_amdgcn_mfma_f32_16x16x32_bf16(vf, pf[qb][kh], o[qb][db], 0, 0, 0);
            }
        CFENCE();
    }
#pragma unroll
    for (int qb = 0; qb < NQB; ++qb) if (qb < nqb) {
        float l = lrun[qb]; l += shx(l, 16, lane); l += shx(l, 32, lane);
        const float inv = 1.f / l; float ss = 0.f; const int row = mixrow0 + 16 * qb + fr;
#pragma unroll
        for (int db = 0; db < 4; ++db) { const f32x4 v = o[qb][db] * inv; ss += (v.x * v.x + v.y * v.y) + (v.z * v.z + v.w * v.w);
            v2u w; w.x = pk2(v.x, v.y); w.y = pk2(v.z, v.w); *(v2u*)(MIX + (size_t)row * DM + ocol + 16 * db + 4 * fq) = w; }
        ss += shx(ss, 16, lane); ss += shx(ss, 32, lane);
        if (fq == 0) SSH[(size_t)row * 16 + sidx] = ss;
    }
}

__device__ __forceinline__ void load_u16(const bf16* up, float (&u)[16]) {
    const v4u a = ((const v4u*)up)[0], b = ((const v4u*)up)[1];
    u[0] = bflo(a.x); u[1] = bfhi(a.x); u[2] = bflo(a.y); u[3] = bfhi(a.y); u[4] = bflo(a.z); u[5] = bfhi(a.z); u[6] = bflo(a.w); u[7] = bfhi(a.w);
    u[8] = bflo(b.x); u[9] = bfhi(b.x); u[10] = bflo(b.y); u[11] = bfhi(b.y); u[12] = bflo(b.z); u[13] = bfhi(b.z); u[14] = bflo(b.w); u[15] = bfhi(b.w);
}
__device__ __forceinline__ void ssm_f1(const bf16* __restrict__ QKV, const unsigned char* ws, int l, int stream, int chunk, int g, int lane) {
    const int pi = (l * 16 + g) * 64 + lane;
    const f32x2 lam = ((const f32x2*)(ws + WS_LAM))[pi];
    float br[16], bi[16];
#pragma unroll
    for (int q = 0; q < 4; ++q) { const f32x4 a = ((const f32x4*)(ws + WS_BBR))[pi * 4 + q], b = ((const f32x4*)(ws + WS_BBI))[pi * 4 + q];
        br[4 * q] = a.x; br[4 * q + 1] = a.y; br[4 * q + 2] = a.z; br[4 * q + 3] = a.w; bi[4 * q] = b.x; bi[4 * q + 1] = b.y; bi[4 * q + 2] = b.z; bi[4 * q + 3] = b.w; }
    float xr = 0.f, xi = 0.f;
    const bf16* up = QKV + (size_t)(stream * 8192 + chunk * 64) * DIN + 1152 + 16 * g;
    for (int t = 0; t < 64; ++t) {
        float u[16]; load_u16(up + (size_t)t * DIN, u);
        float vr = 0.f, vi = 0.f;
#pragma unroll
        for (int h = 0; h < 16; ++h) { vr += br[h] * u[h]; vi += bi[h] * u[h]; }
        const float nr = lam.x * xr - lam.y * xi + vr, ni = lam.x * xi + lam.y * xr + vi; xr = nr; xi = ni;
    }
    ((f32x2*)(ws + WS_SLOC))[((stream * 128 + chunk) * 16 + g) * 64 + lane] = (f32x2){xr, xi};
}
__device__ __forceinline__ void ssm_f2(const bf16* __restrict__ QKV, const unsigned char* ws, bf16* YB, LAS unsigned char* wl, const float* dskip, int l, int g, int ntok, int qrow0, int yrow0,
                                       float hr, float hi, float* fin_re, float* fin_im, int lane) {
    const int fr = lane & 15, fq = lane >> 4;
    const int pi = (l * 16 + g) * 64 + lane;
    const f32x2 lam = ((const f32x2*)(ws + WS_LAM))[pi];
    float br[16], bi[16];
#pragma unroll
    for (int q = 0; q < 4; ++q) { const f32x4 a = ((const f32x4*)(ws + WS_BBR))[pi * 4 + q], b = ((const f32x4*)(ws + WS_BBI))[pi * 4 + q];
        br[4 * q] = a.x; br[4 * q + 1] = a.y; br[4 * q + 2] = a.z; br[4 * q + 3] = a.w; bi[4 * q] = b.x; bi[4 * q + 1] = b.y; bi[4 * q + 2] = b.z; bi[4 * q + 3] = b.w; }
    bf16x8 cf[4];
#pragma unroll
    for (int ks = 0; ks < 4; ++ks) cf[ks] = *(const bf16x8*)((const bf16*)(ws + WS_CCB) + (size_t)((l * 16 + g) * 16 + fr) * 128 + 32 * ks + 8 * fq);
    const f32x4 dv = *(const f32x4*)(dskip + (l * 16 + g) * 16 + 4 * fq);
    float xr = hr, xi = hi;
    for (int half = 0; half < ntok; half += 32) {
        const bf16* up = QKV + (size_t)(qrow0 + half) * DIN + 1152 + 16 * g;
        for (int t = 0; t < 32; ++t) {
            float u[16]; load_u16(up + (size_t)t * DIN, u);
            float vr = 0.f, vi = 0.f;
#pragma unroll
            for (int h = 0; h < 16; ++h) { vr += br[h] * u[h]; vi += bi[h] * u[h]; }
            const float nr = lam.x * xr - lam.y * xi + vr, ni = lam.x * xi + lam.y * xr + vi; xr = nr; xi = ni;
            *(LAS unsigned short*)(wl + t * 272 + lane * 2) = (unsigned short)f2bf(xr);
            *(LAS unsigned short*)(wl + t * 272 + 128 + lane * 2) = (unsigned short)f2bf(xi);
        }
        CFENCE();
#pragma unroll
        for (int tb = 0; tb < 2; ++tb) {
            f32x4 acc = (f32x4){0.f, 0.f, 0.f, 0.f};
#pragma unroll
            for (int ks = 0; ks < 4; ++ks) { const bf16x8 xf = *(const LAS bf16x8*)(wl + (16 * tb + fr) * 272 + (32 * ks + 8 * fq) * 2);
                acc = __builtin_amdgcn_mfma_f32_16x16x32_bf16(cf[ks], xf, acc, 0, 0, 0); }
            const int tl = half + 16 * tb + fr;
            const v2u uw = *(const v2u*)(QKV + (size_t)(qrow0 + tl) * DIN + 1152 + 16 * g + 4 * fq);
            const f32x4 uu = (f32x4){bflo(uw.x), bfhi(uw.x), bflo(uw.y), bfhi(uw.y)};
            f32x4 y = acc + dv * uu;
#pragma unroll
            for (int j = 0; j < 4; ++j) { const float z = 0.7978845608028654f * (y[j] + 0.044715f * y[j] * y[j] * y[j]); y[j] = y[j] * __builtin_amdgcn_rcpf(1.0f + __builtin_amdgcn_exp2f(-2.f * LOG2E * z)); }
            v2u w; w.x = pk2(y.x, y.y); w.y = pk2(y.z, y.w);
            *(v2u*)(YB + (size_t)(yrow0 + tl) * 256 + 16 * g + 4 * fq) = w;
        }
        CFENCE();
    }
    if (fin_re) { fin_re[lane] = xr; fin_im[lane] = xi; }
}

__global__ void __launch_bounds__(NTHREADS, 2) fwd_kernel(Args args) {
    extern __shared__ __attribute__((aligned(16))) unsigned char lds_raw[];
    cg::grid_group grid = cg::this_grid();
    LAS unsigned char* lds = (LAS unsigned char*)lds_raw;
    const int wave0 = __builtin_amdgcn_readfirstlane(threadIdx.x >> 6);
    const int G0 = gridDim.x;
#define MYTID() (wave0 * 64 + lane_id_v())
#define PHASE_IDS() PHASE_PTRS(); int tid_ = MYTID(); asm volatile("" : "+v"(tid_)); const int tid = tid_, lane = tid & 63, wave = __builtin_amdgcn_readfirstlane(tid >> 6); \
    const int gw = bid * NWAVES + wave; const long long gt = (long long)bid * NTHREADS + tid; LAS unsigned char* wl = lds + wave * WAVE_LDS; (void)gw; (void)gt; (void)wl; (void)lane
    unsigned char* const ws0 = args.ws; float* const out0 = args.out;
    { const int t0 = MYTID();
      if (t0 == 0) {
#pragma unroll
          for (int k = 0; k < 25; ++k) ((LAS unsigned long long*)(lds + PTAB_OFF))[k] = (unsigned long long)args.in[k]; } }
    __syncthreads();
#define INP(k) inptr(lds, k)
#define x_p INP(0)
#define x_s INP(1)
#define cak INP(2)
#define cav INP(3)
#define cck INP(4)
#define ccv INP(5)
#define st_re INP(6)
#define st_im INP(7)
#define norm_g INP(8)
#define bng INP(9)
#define w_up INP(10)
#define w_dn INP(11)
#define w_in INP(12)
#define w_out INP(13)
#define relb INP(14)
#define csink INP(15)
#define a_re INP(16)
#define a_im INP(17)
#define log_dt INP(18)
#define b_re INP(19)
#define b_im INP(20)
#define c_re INP(21)
#define c_im INP(22)
#define d_skip INP(23)
#define w_glu INP(24)
#define PHASE_PTRS() unsigned char* ws = ws0; float* out = out0; int G = G0, bid = blockIdx.x; asm volatile("" : "+s"(ws), "+s"(out), "+s"(G), "+s"(bid)); float* const X = out; (void)X; \
    const int NGW = G * NWAVES; const long long GT = (long long)G * NTHREADS; (void)NGW; (void)GT
#define WUP ((bf16*)(ws + WS_WUP))
#define WDN ((bf16*)(ws + WS_WDN))
#define WIN ((bf16*)(ws + WS_WIN))
#define WOUT ((bf16*)(ws + WS_WOUT))
#define WGLU ((bf16*)(ws + WS_WGLU))
#define XN ((bf16*)(ws + WS_XN))
#define OUTB ((bf16*)(ws + WS_OUT))
#define MIX ((bf16*)(ws + WS_MIX))
#define YB ((bf16*)(ws + WS_YB))
#define ACT ((bf16*)(ws + WS_ACT))
#define QKV ((bf16*)(ws + WS_QKV))
#define SSH ((float*)(ws + WS_SSH))

    const int ph_lo = args.ph_lo, ph_hi = args.ph_hi;
#define IN(k) (ph_lo <= (k) && (k) < ph_hi)
#define PH(k) (13 * l + (k))
    if (IN(0)) {
        PHASE_IDS();
        LAS float* scr = (LAS float*)(lds + wave * 16384);
        constexpr int I_UP = 16 * 176, I_DN = 44 * 32, I_IN = 16 * 64, I_OUT = 16 * 32, I_GLU = 4 * 16;
        constexpr int NITEMS = 4 * I_UP + 4 * I_DN + 2 * I_IN + 2 * I_OUT + 2 * I_GLU;
        for (int it = gw; it < NITEMS; it += NGW) {
            int r = it;
            if (r < 4 * I_UP) { const int mi = r / I_UP, q = r % I_UP, kb = q / 176, nb = q % 176; transpose_item(w_up + (size_t)mi * DM * 2 * DFF, DM, 2 * DFF, WUP + (size_t)mi * 2 * DFF * DM, glu_row(nb * 32, DFF), kb * 64, nb * 32, nullptr, scr, lane); continue; } r -= 4 * I_UP;
            if (r < 4 * I_DN) { const int mi = r / I_DN, q = r % I_DN, kb = q / 32, nb = q % 32; transpose_item(w_dn + (size_t)mi * DFF * DM, DFF, DM, WDN + (size_t)mi * DM * DFF, nb * 32, kb * 64, nb * 32, nullptr, scr, lane); continue; } r -= 4 * I_DN;
            if (r < 2 * I_IN) { const int mi = r / I_IN, q = r % I_IN, kb = q / 64, nb = q % 64; transpose_item(w_in + (size_t)mi * DM * DIN, DM, DIN, WIN + (size_t)mi * DIN * DM, nb * 32, kb * 64, nb * 32, nullptr, scr, lane, (nb >= 44 && nb < 60 && (nb & 1) == 0)); continue; } r -= 2 * I_IN;
            if (r < 2 * I_OUT) { const int mi = r / I_OUT, q = r % I_OUT, kb = q / 32, nb = q % 32; transpose_item(w_out + (size_t)mi * DM * DM, DM, DM, WOUT + (size_t)mi * DM * DM, nb * 32, kb * 64, nb * 32, bng + mi * DM, scr, lane); continue; } r -= 2 * I_OUT;
            { const int mi = r / I_GLU, q = r % I_GLU, kb = q / 16, nb = q % 16; transpose_item(w_glu + (size_t)mi * 256 * 512, 256, 512, WGLU + (size_t)mi * 512 * 256, glu_row(nb * 32, 256), kb * 64, nb * 32, nullptr, scr, lane); }
        }
        for (long long i = gt; i < 8192 * 8; i += GT) {
            const float INVF[8] = {1.0f, 0.1939227432012558f, 0.03760603070259094f, 0.007292664609849453f, 0.0014142135623842478f, 0.00027424818836152554f, 5.3182957344688475e-05f, 1.0313385246263351e-05f};
            const int pos = (int)(i >> 3), fi = (int)(i & 7);
            float inv = INVF[0];
#pragma unroll
            for (int k = 1; k < 8; ++k) inv = (fi == k) ? INVF[k] : inv;
            const float ang = (float)pos * inv; const double a = (double)ang;
            ((f32x2*)(ws + WS_ROPE))[i] = (f32x2){(float)cos(a), (float)sin(a)};
        }
        for (long long i = gt; i < 2 * 16 * 64; i += GT) {
            const int lg = (int)(i >> 6);
            const float dt = expf(log_dt[lg]), ar = a_re[i], ai = a_im[i];
            const float mag = expf(ar * dt), ang = ai * dt;
            const float lr = mag * (float)cos((double)ang), li = mag * (float)sin((double)ang);
            const float den = ar * ar + ai * ai;
            const float zr = ((lr - 1.0f) * ar + li * ai) / den, zi = (li * ar - (lr - 1.0f) * ai) / den;
            ((f32x2*)(ws + WS_LAM))[i] = (f32x2){lr, li};
            float pr = lr, pim = li;
#pragma unroll
            for (int k = 0; k < 6; ++k) { const float nr = pr * pr - pim * pim, ni = 2.f * pr * pim; pr = nr; pim = ni; }
            ((f32x2*)(ws + WS_L64))[i] = (f32x2){pr, pim};
            for (int h = 0; h < 16; ++h) { const float brv = b_re[i * 16 + h], biv = b_im[i * 16 + h];
                ((float*)(ws + WS_BBR))[i * 16 + h] = zr * brv - zi * biv; ((float*)(ws + WS_BBI))[i * 16 + h] = zr * biv + zi * brv; }
        }
        for (long long i = gt; i < 2 * 16 * 16 * 128; i += GT) {
            const int k = (int)(i & 127); const long long lgh = i >> 7;
            const float v = (k < 64) ? c_re[lgh * 64 + k] : -c_im[lgh * 64 + (k - 64)];
            ((bf16*)(ws + WS_CCB))[i] = (bf16)f2bf(v);
        }
        for (long long i = gt; i < 2LL * 8 * 480 * 96; i += GT) {
            const long long row = i / 96, c4 = i % 96, lb = row / 480, rr = row % 480;
            ((f32x4*)(out + O_AKS))[(lb * 512 + rr) * 96 + c4] = ((const f32x4*)cak)[(lb * 512 + rr + 32) * 96 + c4];
            ((f32x4*)(out + O_AVS))[(lb * 512 + rr) * 96 + c4] = ((const f32x4*)cav)[(lb * 512 + rr + 32) * 96 + c4];
        }
        for (long long i = gt; i < 2LL * 8 * 96 * 32; i += GT) {
            const long long row = i / 32, c4 = i % 32, lb = row / 96, rr = row % 96;
            ((f32x4*)(out + O_CKS))[(lb * 128 + rr) * 32 + c4] = ((const f32x4*)cck)[(lb * 128 + rr + 32) * 32 + c4];
            ((f32x4*)(out + O_CVS))[(lb * 128 + rr) * 32 + c4] = ((const f32x4*)ccv)[(lb * 128 + rr + 32) * 32 + c4];
        }
        for (int m = gw; m < TT; m += NGW) { const float* xr = (m < TP) ? x_p + (size_t)m * DM : x_s + (size_t)(m - TP) * DM;
            row_pass(xr, X + (size_t)m * DM, nullptr, nullptr, 0.f, XN + (size_t)m * DM, norm_g, lane); }
    }
    if (IN(0) && IN(1)) grid.sync();

    unsigned bar_gen = 0;
#define GBAR() do { ++bar_gen; gbar((unsigned*)(ws0 + WS_CTL) + 64 * args.li, bar_gen * (unsigned)G0, MYTID()); } while (0)
    for (int l = 0; l < 2; ++l) {
#define ng (norm_g + (size_t)l * 6 * DM)
        if (IN(PH(1))) { PHASE_PTRS(); pg8::Gemm g{XN, WUP + (size_t)(l * 2 + 0) * 2 * DFF * DM, TT, 2 * DFF, DM}; pg8::StaticOrder S; S.init(TT, 2 * DFF, G, bid);
          pg8::EpiGlu<0> E{ACT, DFF}; pg8::gemm_phase<pg8::EpiGlu<0>, pg8::StaticOrder, true, true>(lds, g, S, E, MYTID()); }
        if (IN(PH(1)) && IN(PH(1) + 1)) GBAR();
        if (IN(PH(2))) { PHASE_PTRS(); pg8::Gemm g{ACT, WDN + (size_t)(l * 2 + 0) * DM * DFF, TT, DM, DFF}; pg8::StaticOrder S; S.init(TT, DM, G, bid);
          pg8::EpiOut E{OUTB, DM}; pg8::gemm_phase<pg8::EpiOut, pg8::StaticOrder, true, true>(lds, g, S, E, MYTID()); }
        if (IN(PH(2)) && IN(PH(2) + 1)) GBAR();
        if (IN(PH(3))) {
            PHASE_IDS();
            for (int m = gw; m < TT; m += NGW) row_pass(X + (size_t)m * DM, X + (size_t)m * DM, OUTB + (size_t)m * DM, ng + DM, 0.5f, XN + (size_t)m * DM, ng + 2 * DM, lane);
            for (long long i = gt; i < 8LL * 512 * 48; i += GT) { const long long row = i / 48, c8 = i % 48, b = row / 512, r = row % 512;
                const f32x4* sk = (const f32x4*)(cak + ((size_t)(l * 8 + b) * 512 + r) * 384 + c8 * 8); const f32x4* sv = (const f32x4*)(cav + ((size_t)(l * 8 + b) * 512 + r) * 384 + c8 * 8);
                bf16* dq = QKV + (size_t)(TP + b * 544 + r) * DIN;
                const f32x4 k0 = sk[0], k1 = sk[1], v0 = sv[0], v1 = sv[1];
                *(v4u*)(dq + 384 + c8 * 8) = (v4u){pk2(k0.x, k0.y), pk2(k0.z, k0.w), pk2(k1.x, k1.y), pk2(k1.z, k1.w)};
                *(v4u*)(dq + 768 + c8 * 8) = (v4u){pk2(v0.x, v0.y), pk2(v0.z, v0.w), pk2(v1.x, v1.y), pk2(v1.z, v1.w)}; }
            for (long long i = gt; i < 8LL * 128 * 16; i += GT) { const long long row = i / 16, c8 = i % 16, b = row / 128, r = row % 128;
                const f32x4* sk = (const f32x4*)(cck + ((size_t)(l * 8 + b) * 128 + r) * 128 + c8 * 8); const f32x4* sv = (const f32x4*)(ccv + ((size_t)(l * 8 + b) * 128 + r) * 128 + c8 * 8);
                bf16* dq = QKV + (size_t)(TP + b * 544 + 384 + r) * DIN;
                const f32x4 k0 = sk[0], k1 = sk[1], v0 = sv[0], v1 = sv[1];
                *(v4u*)(dq + 1792 + c8 * 8) = (v4u){pk2(k0.x, k0.y), pk2(k0.z, k0.w), pk2(k1.x, k1.y), pk2(k1.z, k1.w)};
                *(v4u*)(dq + 1920 + c8 * 8) = (v4u){pk2(v0.x, v0.y), pk2(v0.z, v0.w), pk2(v1.x, v1.y), pk2(v1.z, v1.w)}; }
        }
        if (IN(PH(3)) && IN(PH(3) + 1)) GBAR();
        if (IN(PH(4))) { PHASE_PTRS(); pg8::Gemm g{XN, WIN + (size_t)l * DIN * DM, TT, DIN, DM}; pg8::StaticOrder S; S.init(TT, DIN, G, bid);
          pg8::EpiQKV E{QKV, (const pg8::f32x2*)(ws + WS_ROPE), out, l};
          pg8::gemm_phase<pg8::EpiQKV, pg8::StaticOrder, true, true>(lds, g, S, E, MYTID()); }
        if (IN(PH(4)) && IN(PH(4) + 1)) GBAR();
        if (IN(PH(5))) { PHASE_IDS(); for (int u = gw; u < 4 * 128 * 16; u += NGW) ssm_f1(QKV, ws, l, u >> 11, (u >> 4) & 127, u & 15, lane); }
        if (IN(PH(5)) && IN(PH(5) + 1)) GBAR();
        if (IN(PH(6))) {
            PHASE_IDS();
            LAS float* tab = (LAS float*)(lds + TAB_OFF);
            for (int i = tid; i < 6 * 257; i += NTHREADS) tab[i] = relb[(size_t)l * 6 * 257 + i] * LOG2E;
            __syncthreads();
            constexpr int NATT = 8192 + 64, NSSM = 8192 + 128;
            for (int uid = gw; uid < NATT + NSSM; uid += NGW) {
                if (uid < NATT) {
                    const int sub = uid & 7;
                    int srow0, qpos0, cstart, kend, mixrow0;
                    if (uid < 8192) { const int rest = uid >> 3, half = rest & 1, ci = rest >> 1, st = ci >> 7, n = ci & 127; srow0 = st * 8192; cstart = 64 * n; qpos0 = cstart + 32 * half; kend = cstart + 64; mixrow0 = st * 8192 + qpos0; }
                    else { const int b = (uid - 8192) >> 3; srow0 = TP + b * 544; cstart = 512; qpos0 = 512; kend = 544; mixrow0 = TP + 32 * b; }
                    if (sub < 6) { int kt0 = cstart - 512; kt0 = kt0 < 0 ? 0 : kt0;
                        attn_unit<2>(QKV, MIX, SSH, wl, tab + 257 * sub, true, srow0, qpos0, kt0, kend, 64 * sub, 384 + 64 * sub, 768 + 64 * sub, 64 * sub, sub, mixrow0, -1e30f, false, lane); }
                    else { const int kh = sub - 6; int kt0 = cstart - 128; kt0 = kt0 < 0 ? 0 : kt0;
                        for (int gq = 0; gq < 3; ++gq) { const int qh = 3 * kh + gq;
                            attn_unit<2>(QKV, MIX, SSH, wl, tab, false, srow0, qpos0, kt0, kend, 1408 + 64 * qh, 1792 + 64 * kh, 1920 + 64 * kh, 640 + 64 * qh, 6 + qh, mixrow0, csink[l * 6 + qh] * LOG2E, true, lane); } }
                } else {
                    const int s = uid - NATT;
                    if (s < 8192) { const int g = s & 15, chunk = (s >> 4) & 127, st = s >> 11;
                        const f32x2 l64 = ((const f32x2*)(ws + WS_L64))[(l * 16 + g) * 64 + lane];
                        float hr = 0.f, hi = 0.f; const f32x2* sl = (const f32x2*)(ws + WS_SLOC) + ((size_t)(st * 128) * 16 + g) * 64 + lane;
                        for (int c = 0; c < chunk; ++c) { const f32x2 sv = sl[(size_t)c * 1024]; const float nr = l64.x * hr - l64.y * hi + sv.x, ni = l64.x * hi + l64.y * hr + sv.y; hr = nr; hi = ni; }
                        const bool fin = (chunk == 127);
                        ssm_f2(QKV, ws, YB, wl, d_skip, l, g, 64, st * 8192 + chunk * 64, st * 8192 + chunk * 64, hr, hi,
                               fin ? out + O_SRP + ((size_t)(l * 4 + st) * 16 + g) * 64 : nullptr, fin ? out + O_SIP + ((size_t)(l * 4 + st) * 16 + g) * 64 : nullptr, lane);
                    } else { const int s2 = s - 8192, b = s2 >> 4, g = s2 & 15; const size_t hidx = ((size_t)(l * 8 + b) * 16 + g) * 64;
                        ssm_f2(QKV, ws, YB, wl, d_skip, l, g, 32, TP + b * 544 + 512, TP + 32 * b, st_re[hidx + lane], st_im[hidx + lane], out + O_SRS + hidx, out + O_SIS + hidx, lane); }
                }
            }
        }
        if (IN(PH(6)) && IN(PH(6) + 1)) GBAR();
        if (IN(PH(7))) { PHASE_PTRS(); pg8::Gemm g{YB, WGLU + (size_t)l * 512 * 256, TT, 512, 256}; pg8::StaticOrder S; S.init(TT, 512, G, bid);
          pg8::EpiGlu<1> E{MIX + 384, DM}; pg8::gemm_phase<pg8::EpiGlu<1>, pg8::StaticOrder, true, true>(lds, g, S, E, MYTID()); }
        if (IN(PH(7)) && IN(PH(7) + 1)) GBAR();
        if (IN(PH(8))) { PHASE_IDS(); for (int m = gw; m < TT; m += NGW) {
            const f32x4* sp = (const f32x4*)(SSH + (size_t)m * 16); const f32x4 s0 = sp[0], s1 = sp[1], s2 = sp[2];
            const float ra = __builtin_amdgcn_rsqf(((s0.x + s0.y) + (s0.z + s0.w) + (s1.x + s1.y)) * (1.f / 384.f) + EPSN);
            const float rc = __builtin_amdgcn_rsqf(((s1.z + s1.w) + (s2.x + s2.y) + (s2.z + s2.w)) * (1.f / 384.f) + EPSN);
            v4u* mp = (v4u*)(MIX + (size_t)m * DM);
            v4u w[2]; float sb = 0.f;
#pragma unroll
            for (int j = 0; j < 2; ++j) { const int c = lane + 64 * j; w[j] = mp[c];
                if (c >= 48 && c < 80) { const float a0 = bflo(w[j].x), a1 = bfhi(w[j].x), a2 = bflo(w[j].y), a3 = bfhi(w[j].y), a4 = bflo(w[j].z), a5 = bfhi(w[j].z), a6 = bflo(w[j].w), a7 = bfhi(w[j].w);
                    sb += (a0 * a0 + a1 * a1) + (a2 * a2 + a3 * a3) + (a4 * a4 + a5 * a5) + (a6 * a6 + a7 * a7); } }
            const float rb = __builtin_amdgcn_rsqf(wave_sum(sb, lane) * (1.f / 256.f) + EPSN);
#pragma unroll
            for (int j = 0; j < 2; ++j) { const int c = lane + 64 * j; const float r = (c < 48) ? ra : ((c < 80) ? rb : rc); v4u x = w[j];
                x.x = pk2(bflo(x.x) * r, bfhi(x.x) * r); x.y = pk2(bflo(x.y) * r, bfhi(x.y) * r); x.z = pk2(bflo(x.z) * r, bfhi(x.z) * r); x.w = pk2(bflo(x.w) * r, bfhi(x.w) * r); mp[c] = x; }
        } }
        if (IN(PH(8)) && IN(PH(8) + 1)) GBAR();
        if (IN(PH(9))) { PHASE_PTRS(); pg8::Gemm g{MIX, WOUT + (size_t)l * DM * DM, TT, DM, DM}; pg8::StaticOrder S; S.init(TT, DM, G, bid);
          pg8::EpiOut E{OUTB, DM}; pg8::gemm_phase<pg8::EpiOut, pg8::StaticOrder, true, true>(lds, g, S, E, MYTID()); }
        if (IN(PH(9)) && IN(PH(9) + 1)) GBAR();
        if (IN(PH(10))) { PHASE_IDS(); for (int m = gw; m < TT; m += NGW) row_pass(X + (size_t)m * DM, X + (size_t)m * DM, OUTB + (size_t)m * DM, ng + 3 * DM, 1.0f, XN + (size_t)m * DM, ng + 4 * DM, lane); }
        if (IN(PH(10)) && IN(PH(10) + 1)) GBAR();
        if (IN(PH(11))) { PHASE_PTRS(); pg8::Gemm g{XN, WUP + (size_t)(l * 2 + 1) * 2 * DFF * DM, TT, 2 * DFF, DM}; pg8::StaticOrder S; S.init(TT, 2 * DFF, G, bid);
          pg8::EpiGlu<0> E{ACT, DFF}; pg8::gemm_phase<pg8::EpiGlu<0>, pg8::StaticOrder, true, true>(lds, g, S, E, MYTID()); }
        if (IN(PH(11)) && IN(PH(11) + 1)) GBAR();
        if (IN(PH(12))) { PHASE_PTRS(); pg8::Gemm g{ACT, WDN + (size_t)(l * 2 + 1) * DM * DFF, TT, DM, DFF}; pg8::StaticOrder S; S.init(TT, DM, G, bid);
          pg8::EpiOut E{OUTB, DM}; pg8::gemm_phase<pg8::EpiOut, pg8::StaticOrder, true, true>(lds, g, S, E, MYTID()); }
        if (IN(PH(12)) && IN(PH(12) + 1)) GBAR();
        if (IN(PH(13))) { PHASE_IDS(); for (int m = gw; m < TT; m += NGW) row_pass(X + (size_t)m * DM, X + (size_t)m * DM, OUTB + (size_t)m * DM, ng + 5 * DM, 0.5f, XN + (size_t)m * DM, (l == 0) ? norm_g + 6 * DM : nullptr, lane); }
        if (IN(PH(13)) && IN(PH(13) + 1)) GBAR();
    }
}

#ifdef DBG
__device__ __forceinline__ float b2f(bf16 v) { return __builtin_bit_cast(float, ((unsigned)v) << 16); }
struct DbgAcc { double num, den; };
__device__ __forceinline__ void dacc(DbgAcc& a, double fast, double ref) { a.num += (fast - ref) * (fast - ref); a.den += ref * ref; }
__device__ __forceinline__ void dcommit(unsigned* word, unsigned module, const DbgAcc& a) { if (!(a.num <= 1e-3 * a.den + 1e-14)) { if (*word > module) *word = module; } }

#define DBG_COL(ci) ((ci) == 0 ? 3 : ((ci) == 1 ? 1500 : 2815))
__device__ __forceinline__ void dbg_m1(unsigned* word, const bf16* XNp, const float* wup, const bf16* ACTp) {
    DbgAcc a{0, 0};
    for (int ri = 0; ri < 3; ++ri) for (int ci = 0; ci < 3; ++ci) { const int r = (ri == 0) ? 5 : ((ri == 1) ? 20000 : 32900), c = DBG_COL(ci); double g = 0, u = 0;
        for (int k = 0; k < 1024; ++k) { const double x = b2f(XNp[(size_t)r * 1024 + k]); g += x * wup[(size_t)k * 5632 + c]; u += x * wup[(size_t)k * 5632 + 2816 + c]; }
        dacc(a, b2f(ACTp[(size_t)r * 2816 + c]), g / (1.0 + exp(-g)) * u); }
    dcommit(word, 1, a);
}
#undef DBG_COL
#define DBG_COL(ci) ((ci) == 0 ? 7 : 700)
__device__ __forceinline__ void dbg_m2(unsigned* word, const bf16* ACTp, const float* wdn, const bf16* OUTp) {
    DbgAcc a{0, 0};
    for (int ri = 0; ri < 3; ++ri) for (int ci = 0; ci < 2; ++ci) { const int r = (ri == 0) ? 5 : ((ri == 1) ? 20000 : 32900), c = DBG_COL(ci); double s = 0;
        for (int k = 0; k < 2816; ++k) s += (double)b2f(ACTp[(size_t)r * 2816 + k]) * wdn[(size_t)k * 1024 + c];
        dacc(a, b2f(OUTp[(size_t)r * 1024 + c]), s); }
    dcommit(word, 2, a);
}
__device__ __forceinline__ void dbg_m3(unsigned* word, const float* Xp, const bf16* XNp, const float* gb) {
    DbgAcc a{0, 0};
    for (int ri = 0; ri < 3; ++ri) { const int r = (ri == 0) ? 5 : ((ri == 1) ? 20000 : 32900); double ss = 0; for (int k = 0; k < 1024; ++k) ss += (double)Xp[(size_t)r * 1024 + k] * Xp[(size_t)r * 1024 + k];
        const double rs = 1.0 / sqrt(ss / 1024 + 1e-6);
        for (int c = 1; c < 1024; c += 337) dacc(a, b2f(XNp[(size_t)r * 1024 + c]), Xp[(size_t)r * 1024 + c] * rs * gb[c]); }
    dcommit(word, 3, a);
}
__device__ __forceinline__ void dbg_m4(unsigned* word, const bf16* XNp, const float* win, const bf16* Qp, const float* outp, int l, const float* ropet) {
    const double QS = 0.125 * 1.4426950408889634;
    unsigned code = 99;
    for (int ci = 5; ci >= 0; --ci) { DbgAcc a{0, 0};
        const int c = (ci == 0) ? 1428 : (ci == 1) ? 1930 : (ci == 2) ? 1832 : (ci == 3) ? 1507 : (ci == 4) ? 1408 + 16 : 1792 + 16;
        for (int ri = 0; ri < 3; ++ri) { const int r = (ri == 0) ? 5 : ((ri == 1) ? 20000 : 32900); int qrow;
            if (r < 32768) { qrow = r; } else { const int s = r - 32768, b = s >> 5, t = s & 31; qrow = 32768 + b * 544 + 512 + t; }
            double v = 0; const bool isq = (c < 384) || (c >= 1408 && c < 1792);
            for (int k = 0; k < 1024; ++k) { const double x = b2f(XNp[(size_t)r * 1024 + k]); v += x * win[(size_t)k * 2048 + c]; }
            dacc(a, b2f(Qp[(size_t)qrow * 2048 + c]), isq ? v * QS : v); }
        if (!(a.num <= 1e-3 * a.den)) code = 1 + ci; }
    *word = code;
}
__device__ __forceinline__ void dbg_attn(unsigned* word, unsigned module, const bf16* Qp, const bf16* MIXp, const float* relb_l  , const float* sinkp  ,
                                      int srow0, int qpos, int kstart, int kend, int qcol, int kcol, int vcol, int ocol, int mixrow, int head) {
    DbgAcc a{0, 0};
    double mx = -1e300;
    for (int pass = 0; pass < 2; ++pass) {
        double den = 0, o0 = 0, o1 = 0;
        for (int kp = kstart; kp < kend; ++kp) { double s = 0;
            for (int d = 0; d < 64; ++d) s += (double)b2f(Qp[(size_t)(srow0 + qpos) * 2048 + qcol + d]) * b2f(Qp[(size_t)(srow0 + kp) * 2048 + kcol + d]);
            if (relb_l) { int rel = qpos - kp; rel = rel < -128 ? -128 : (rel > 128 ? 128 : rel); s += (double)relb_l[head * 257 + rel + 128] * 1.4426950408889634; }
            if (pass == 0) { if (s > mx) mx = s; } else { const double p = exp2(s - mx); den += p; o0 += p * b2f(Qp[(size_t)(srow0 + kp) * 2048 + vcol + 0]); o1 += p * b2f(Qp[(size_t)(srow0 + kp) * 2048 + vcol + 33]); } }
        if (pass == 0) { if (sinkp) { const double sk = (double)sinkp[0] * 1.4426950408889634; if (sk > mx) mx = sk; } }
        else { if (sinkp) den += exp2((double)sinkp[0] * 1.4426950408889634 - mx);
            dacc(a, b2f(MIXp[(size_t)mixrow * 1024 + ocol + 0]), o0 / den); dacc(a, b2f(MIXp[(size_t)mixrow * 1024 + ocol + 33]), o1 / den); } }
    dcommit(word, module, a);
}
__device__ __forceinline__ void dbg_ssm(unsigned* word, const bf16* Qp, const bf16* YBp, const float* are, const float* aim, const float* ldt, const float* bre, const float* bim, const float* cre, const float* cim, const float* dsk,
                                     const float* h0re, const float* h0im, int l, int g, int h, int qrow0, int yrow0, int ttarget, const float* fin_re, int fin_steps) {
    DbgAcc a{0, 0}; double y = 0;
    const double dt = exp((double)ldt[l * 16 + g]);
    for (int p = 0; p < 64; ++p) { const int i = (l * 16 + g) * 64 + p; const double ar = are[i], ai = aim[i]; const double mag = exp(ar * dt), lr = mag * cos(ai * dt), li = mag * sin(ai * dt);
        const double den = ar * ar + ai * ai, zr = ((lr - 1) * ar + li * ai) / den, zi = (li * ar - (lr - 1) * ai) / den;
        double xr = h0re ? (double)h0re[p] : 0.0, xi = h0im ? (double)h0im[p] : 0.0;
        const int nst = (p == 9 && fin_re) ? fin_steps : ttarget + 1;
        for (int t = 0; t < nst; ++t) { double vr = 0, vi = 0;
            for (int hh = 0; hh < 16; ++hh) { const double u = b2f(Qp[(size_t)(qrow0 + t) * 2048 + 1152 + 16 * g + hh]); const double br = bre[(size_t)i * 16 + hh], bi = bim[(size_t)i * 16 + hh]; vr += (zr * br - zi * bi) * u; vi += (zr * bi + zi * br) * u; }
            const double nr = lr * xr - li * xi + vr, ni = lr * xi + li * xr + vi; xr = nr; xi = ni;
            if (t == ttarget) y += cre[((size_t)(l * 16 + g) * 16 + h) * 64 + p] * xr - cim[((size_t)(l * 16 + g) * 16 + h) * 64 + p] * xi; }
        if (p == 9 && fin_re) dacc(a, fin_re[9], xr); }
    y += (double)dsk[(l * 16 + g) * 16 + h] * b2f(Qp[(size_t)(qrow0 + ttarget) * 2048 + 1152 + 16 * g + h]);
    const double z = 0.7978845608028654 * (y + 0.044715 * y * y * y), ge = 0.5 * y * (1.0 + tanh(z));
    dacc(a, b2f(YBp[(size_t)(yrow0 + ttarget) * 256 + 16 * g + h]), ge);
    dcommit(word, 7, a);
}
#undef DBG_COL
#define DBG_COL(ci) ((ci) == 0 ? 7 : 200)
__device__ __forceinline__ void dbg_m8(unsigned* word, const bf16* YBp, const float* wglu, const bf16* MIXp) {
    DbgAcc a{0, 0};
    for (int ri = 0; ri < 3; ++ri) for (int ci = 0; ci < 2; ++ci) { const int r = (ri == 0) ? 5 : ((ri == 1) ? 20000 : 32900), c = DBG_COL(ci); double g1 = 0, g2 = 0;
        for (int k = 0; k < 256; ++k) { const double x = b2f(YBp[(size_t)r * 256 + k]); g1 += x * wglu[(size_t)k * 512 + c]; g2 += x * wglu[(size_t)k * 512 + 256 + c]; }
        dacc(a, b2f(MIXp[(size_t)r * 1024 + 384 + c]), g1 / (1.0 + exp(-g2))); }
    dcommit(word, 8, a);
}
#undef DBG_COL
#define DBG_COL(ci) ((ci) == 0 ? 7 : 700)
__device__ __forceinline__ void dbg_m9(unsigned* word, const bf16* MIXp, const float* wout, const float* gbp, const bf16* OUTp) {
    DbgAcc a{0, 0};
    for (int ri = 0; ri < 3; ++ri) for (int ci = 0; ci < 2; ++ci) { const int r = (ri == 0) ? 5 : ((ri == 1) ? 20000 : 32900), c = DBG_COL(ci); double s = 0;
        for (int k = 0; k < 1024; ++k) s += (double)b2f(MIXp[(size_t)r * 1024 + k]) * gbp[k] * wout[(size_t)k * 1024 + c];
        dacc(a, b2f(OUTp[(size_t)r * 1024 + c]), s); }
    dcommit(word, 9, a);
}
#endif

#ifdef DBG
#ifndef DBG_NPH
#define DBG_NPH 27
#endif
#define DBGW ((unsigned*)(ws + WS_CTL + 32768))
__global__ void dbg_kernel(Args args, int ph) {
    if (threadIdx.x != 0) return;
    unsigned char* ws = args.ws; float* out = args.out; float* X = out;
    const float *w_up_ = args.in[10], *w_dn_ = args.in[11], *w_in_ = args.in[12], *w_out_ = args.in[13], *relb_ = args.in[14], *csink_ = args.in[15], *w_glu_ = args.in[24];
    if (ph == 0) { *DBGW = 99u; return; }
    if (ph > 13) return;
    const int l = 0;
    if (ph != 4) return;
    if (ph == 1) dbg_m1(DBGW, XN, w_up_, ACT);
    if (ph == 2) dbg_m2(DBGW, ACT, w_dn_, OUTB);
    if (ph == 3) dbg_m3(DBGW, X, XN, args.in[8] + 2 * DM);
    if (ph == 4) dbg_m4(DBGW, XN, w_in_, QKV, out, l, (const float*)(ws + WS_ROPE));
    if (ph == 6) {
        dbg_attn(DBGW, 5, QKV, MIX, relb_, nullptr, 8192, 700, 128, 704, 64 * 2, 384 + 64 * 2, 768 + 64 * 2, 64 * 2, 8192 + 700, 2);
        dbg_attn(DBGW, 5, QKV, MIX, relb_, nullptr, TP + 3 * 544, 512 + 7, 0, 544, 64 * 5, 384 + 64 * 5, 768 + 64 * 5, 64 * 5, TP + 3 * 32 + 7, 5);
        dbg_attn(DBGW, 6, QKV, MIX, nullptr, csink_ + 4, 2 * 8192, 100, 0, 128, 1408 + 64 * 4, 1792 + 64, 1920 + 64, 640 + 64 * 4, 2 * 8192 + 100, 0);
        dbg_attn(DBGW, 6, QKV, MIX, nullptr, csink_ + 1, TP + 6 * 544, 512 + 20, 384, 544, 1408 + 64 * 1, 1792, 1920, 640 + 64 * 1, TP + 6 * 32 + 20, 0);
        dbg_ssm(DBGW, QKV, YB, args.in[16], args.in[17], args.in[18], args.in[19], args.in[20], args.in[21], args.in[22], args.in[23], nullptr, nullptr, 0, 3, 5, 0, 0, 150, out + O_SRP + (size_t)3 * 64, 8192);
        dbg_ssm(DBGW, QKV, YB, args.in[16], args.in[17], args.in[18], args.in[19], args.in[20], args.in[21], args.in[22], args.in[23], args.in[6] + (size_t)(2 * 16 + 7) * 64, args.in[7] + (size_t)(2 * 16 + 7) * 64, 0, 7, 2, TP + 2 * 544 + 512, TP + 2 * 32, 9, out + O_SRS + (size_t)(2 * 16 + 7) * 64, 32);
    }
    if (ph == 7) dbg_m8(DBGW, YB, w_glu_, MIX);
    if (ph == 9) dbg_m9(DBGW, MIX, w_out_, args.in[9], OUTB);
}
__global__ void dbg_encode(Args args) {
    unsigned char* ws = args.ws; float* out = args.out;
    const unsigned code = *DBGW;
    if (code >= 99u) return;
    const float sc = 1.4f + 0.05f * (float)(code - 1u);
    for (long long i = (long long)blockIdx.x * blockDim.x + threadIdx.x; i < 2LL * 8 * 480 * 384; i += (long long)gridDim.x * blockDim.x) { const long long row = i / 384, c = i % 384, lb = row / 480, rr = row % 480; out[O_AKS + (lb * 512 + rr) * 384 + c] *= sc; }
}
#endif

extern "C" void kernel_launch(void* const* d_in, const int* in_sizes, int n_in, void* d_out, int out_size, void* d_ws, size_t ws_size, hipStream_t stream) {
    static int grid = 0;
    if (grid == 0) {
        int dev = 0, cus = 0, per_cu = 0;
        if (hipGetDevice(&dev) != hipSuccess || hipDeviceGetAttribute(&cus, hipDeviceAttributeMultiprocessorCount, dev) != hipSuccess) { fprintf(stderr, "device query failed\n"); grid = -1; return; }
        if (hipFuncSetAttribute((const void*)fwd_kernel, hipFuncAttributeMaxDynamicSharedMemorySize, LDS_BYTES) != hipSuccess) { fprintf(stderr, "hipFuncSetAttribute failed\n"); grid = -1; return; }
        if (hipOccupancyMaxActiveBlocksPerMultiprocessor(&per_cu, (const void*)fwd_kernel, NTHREADS, LDS_BYTES) != hipSuccess || per_cu < 1) { fprintf(stderr, "occupancy query: %d\n", per_cu); per_cu = 1; }
        (void)hipGetLastError();
        grid = cus;
        if (n_in != 25 || ws_size < WS_END || out_size != 44089344) { fprintf(stderr, "unexpected problem: n_in %d ws %zu out %d\n", n_in, ws_size, out_size); grid = -1; return; }
    }
    if (grid < 0) return;
    if (hipMemsetAsync((char*)d_ws + WS_CTL, 0, 65536, stream) != hipSuccess) { fprintf(stderr, "memset failed\n"); return; }
    Args a{};
    for (int i = 0; i < 25; ++i) a.in[i] = (const float*)d_in[i];
    a.out = (float*)d_out; a.ws = (unsigned char*)d_ws;
#ifdef DBG
    for (int ph = 0; ph < DBG_NPH; ++ph) {
        a.ph_lo = ph; a.ph_hi = ph + 1; a.li = ph;
        void* kargs[] = {&a};
        if (hipLaunchCooperativeKernel((const void*)fwd_kernel, dim3(grid), dim3(NTHREADS), kargs, LDS_BYTES, stream) != hipSuccess) fprintf(stderr, "cooperative launch failed\n");
        hipLaunchKernelGGL(dbg_kernel, dim3(1), dim3(64), 0, stream, a, ph);
    }
    hipLaunchKernelGGL(dbg_encode, dim3(256), dim3(256), 0, stream, a);
#else
    a.ph_lo = 0; a.ph_hi = 27; a.li = 0;
    void* kargs[] = {&a};
    const hipError_t e = hipLaunchCooperativeKernel((const void*)fwd_kernel, dim3(grid), dim3(NTHREADS), kargs, LDS_BYTES, stream);
    if (e != hipSuccess) fprintf(stderr, "cooperative launch failed: %s (grid %d)\n", hipGetErrorString(e), grid);
#endif
}
```

```cpp
#include <hip/hip_runtime.h>
#include <hip/hip_cooperative_groups.h>
#include <cstdio>
#include <cstdint>
namespace cg = cooperative_groups;
namespace pg8 {
#define PG8_LAS __attribute__((address_space(3)))
typedef unsigned short bf16_t;
typedef short bf16x8 __attribute__((ext_vector_type(8)));
typedef float f32x4 __attribute__((ext_vector_type(4)));
typedef unsigned u32x4 __attribute__((ext_vector_type(4)));
constexpr int BM = 256, BK = 64, HALF = 128, HTB = HALF * BK * 2  , STAGE_BYTES = 8 * HTB, NXCD = 8, WGM = 8;

__host__ __device__ __forceinline__ int lds_byte(int r, int c) { const int st = (r >> 4) * 2 + (c >> 5), rr = r & 15, cc = c & 31, ob = rr * 64 + cc * 2; return st * 1024 + (ob ^ (((ob >> 9) & 1) << 5)); }
__host__ __device__ __forceinline__ void stage_rc(int b, int& R, int& C) { const int st = b / 1024, sb = b % 1024, swz = sb ^ (((sb >> 9) & 1) << 5); R = (st >> 1) * 16 + swz / 64; C = (st & 1) * 32 + (swz % 64) / 2; }
__host__ __device__ __forceinline__ int perm32(int rho) { const int n = rho >> 4, i = rho & 15; return 8 * (i >> 2) + 4 * n + (i & 3); }

struct Unit { int pm, pn, kofs; };
struct Gemm { const bf16_t* A; const bf16_t* Bt; int M, N, K, ld; };

struct StaticOrder {
    int nM, nN, nwg, G, c;
    __host__ __device__ void init(int M, int N, int G_, int c_) { nM = M / BM; nN = N / BM; nwg = nM * nN; G = G_; c = c_; }
    __host__ __device__ bool next(int i, Unit& u) const {
        const long L = (long)i * G + c; if (L >= nwg) return false;
        int wgid = (int)L; { const int q = nwg / NXCD, r = nwg % NXCD, xcd = wgid % NXCD, off = wgid / NXCD; wgid = (xcd < r ? xcd * (q + 1) : r * (q + 1) + (xcd - r) * q) + off; }
        const int nig = WGM * nN, gid = wgid / nig, fm = gid * WGM, gsz = (nM - fm) < WGM ? (nM - fm) : WGM;
        u.pm = fm + ((wgid % nig) % gsz); u.pn = (wgid % nig) / gsz; u.kofs = 0; return true;
    }
    __device__ __forceinline__ void a_ready(const Unit&) const {}
    __device__ __forceinline__ void done(const Unit&) const {}
};
__device__ __forceinline__ unsigned cvt_pk_bf16(float lo, float hi) { unsigned r; asm volatile("v_cvt_pk_bf16_f32 %0, %1, %2" : "=v"(r) : "v"(lo), "v"(hi)); return r; }

typedef float f32x2 __attribute__((ext_vector_type(2)));
__device__ __forceinline__ float fast_sigmoid(float x) { return __builtin_amdgcn_rcpf(1.0f + __builtin_amdgcn_exp2f(-1.4426950408889634f * x)); }

struct EpiOut {
    static constexpr bool PERM = true, AFTER_DRAIN = false;
    bf16_t* O; int ldc;
    __device__ __forceinline__ void operator()(const f32x4 (&acc)[2][2][4][2], const Unit& u, int wr, int wc, int fr, int fq) const {
        const int row0 = u.pm * BM + wr * 64 + fr, col0 = u.pn * BM + wc * 32 + 8 * fq;
#pragma unroll
        for (int ai = 0; ai < 2; ++ai)
#pragma unroll
            for (int m = 0; m < 4; ++m) { bf16_t* rowp = O + (size_t)(row0 + ai * HALF + m * 16) * ldc + col0;
#pragma unroll
                for (int bj = 0; bj < 2; ++bj) { const f32x4 v0 = acc[ai][bj][m][0], v1 = acc[ai][bj][m][1];
                    u32x4 w; w.x = cvt_pk_bf16(v0[0], v0[1]); w.y = cvt_pk_bf16(v0[2], v0[3]); w.z = cvt_pk_bf16(v1[0], v1[1]); w.w = cvt_pk_bf16(v1[2], v1[3]);
                    *(u32x4*)(rowp + bj * HALF) = w; } }
    }
};

template <int MODE> struct EpiGlu {
    static constexpr bool PERM = true, AFTER_DRAIN = false;
    bf16_t* O; int ldc; float* ss;
    __device__ __forceinline__ void operator()(const f32x4 (&acc)[2][2][4][2], const Unit& u, int wr, int wc, int fr, int fq) const {
        const int row0 = u.pm * BM + wr * 64 + fr, col0 = u.pn * HALF + wc * 32 + 8 * fq;
        const int a16 = (((fq ^ 1) << 4) | fr) << 2, a32 = (((fq ^ 2) << 4) | fr) << 2;
#pragma unroll
        for (int ai = 0; ai < 2; ++ai)
#pragma unroll
            for (int m = 0; m < 4; ++m) { const int row = row0 + ai * HALF + m * 16;
                float o[8];
#pragma unroll
                for (int n = 0; n < 2; ++n)
#pragma unroll
                    for (int j = 0; j < 4; ++j) { const float a = acc[ai][0][m][n][j], b = acc[ai][1][m][n][j];
                        o[4 * n + j] = (MODE == 0) ? a * fast_sigmoid(a) * b : a * fast_sigmoid(b); }
                u32x4 w; w.x = cvt_pk_bf16(o[0], o[1]); w.y = cvt_pk_bf16(o[2], o[3]); w.z = cvt_pk_bf16(o[4], o[5]); w.w = cvt_pk_bf16(o[6], o[7]);
                *(u32x4*)(O + (size_t)row * ldc + col0) = w;
                if (MODE == 1) { float s = ((o[0] * o[0] + o[1] * o[1]) + (o[2] * o[2] + o[3] * o[3])) + ((o[4] * o[4] + o[5] * o[5]) + (o[6] * o[6] + o[7] * o[7]));
                    s += __builtin_bit_cast(float, __builtin_amdgcn_ds_bpermute(a16, __builtin_bit_cast(int, s)));
                    s += __builtin_bit_cast(float, __builtin_amdgcn_ds_bpermute(a32, __builtin_bit_cast(int, s)));
                    if (fq == 0) ss[(size_t)row * 8 + u.pn * 4 + wc] = s; }
            }
    }
};

struct EpiQKV {
    static constexpr bool PERM = true, AFTER_DRAIN = false;
    bf16_t* Q; const f32x2* rope; float* out; int l;
    __device__ __forceinline__ void operator()(const f32x4 (&acc)[2][2][4][2], const Unit& u, int wr, int wc, int fr, int fq) const {
        const float QS = 0.125f * 1.4426950408889634f;
        const bool samp = u.pm >= 128;
        const int oak = samp ? 37240832 + l * 1572864 : 33816576 + l * 786432;
        const int oav = samp ? 40386560 + l * 1572864 : 35389440 + l * 786432;
        const int ock = samp ? 43532288 + l * 131072 : 36962304 + l * 65536;
        const int ocv = samp ? 43794432 + l * 131072 : 37093376 + l * 65536;
#pragma unroll
        for (int ai = 0; ai < 2; ++ai)
#pragma unroll
            for (int m = 0; m < 4; ++m) {
                const int r = u.pm * BM + ai * HALF + wr * 64 + m * 16 + fr;
                int b, t, qrow, pos, arow, crow;
                if (!samp) { b = r >> 13; t = r & 8191; qrow = r; pos = t; arow = (t >= 7680) ? b * 512 + t - 7680 : -1; crow = (t >= 8064) ? b * 128 + t - 8064 : -1; }
                else { const int s = r - 32768; b = s >> 5; t = s & 31; qrow = 32768 + b * 544 + 512 + t; pos = 1024 + t; arow = b * 512 + 480 + t; crow = b * 128 + 96 + t; }
#pragma unroll
                for (int bj = 0; bj < 2; ++bj) {
                    const int cb = 2 * u.pn + bj, gcol = cb * 128 + wc * 32;
                    f32x4 pa = acc[ai][bj][m][0], pb = acc[ai][bj][m][1]; int ca_ = gcol + 8 * fq, cb_ = ca_ + 4;
                    if (cb >= 11 && cb <= 14 && (wc & 1) == 0 && fq < 2) {
                        const f32x4* rp = (const f32x4*)(rope + (size_t)pos * 8) + 2 * fq; const f32x4 t0 = rp[0], t1 = rp[1];
                        const f32x4 x1 = (f32x4){pa[0], pa[2], pb[0], pb[2]}, x2 = (f32x4){pa[1], pa[3], pb[1], pb[3]};
                        const f32x4 cs = (f32x4){t0[0], t0[2], t1[0], t1[2]}, sn = (f32x4){t0[1], t0[3], t1[1], t1[3]};
                        pa = x1 * cs - x2 * sn; pb = x2 * cs + x1 * sn; ca_ = gcol + 4 * fq; cb_ = gcol + 8 + 4 * fq; }
                    int dbase = -1;
                    if (cb >= 3 && cb <= 5) { if (arow >= 0) dbase = oak + arow * 384 - 384; }
                    else if (cb >= 6 && cb <= 8) { if (arow >= 0) dbase = oav + arow * 384 - 768; }
                    else if (cb == 14) { if (crow >= 0) dbase = ock + crow * 128 - 1792; }
                    else if (cb == 15) { if (crow >= 0) dbase = ocv + crow * 128 - 1920; }
                    if (dbase >= 0) { *(f32x4*)(out + (dbase + ca_)) = pa; *(f32x4*)(out + (dbase + cb_)) = pb; }
                    if (cb < 3 || (cb >= 11 && cb <= 13)) { pa = pa * QS; pb = pb * QS; }
                    typedef unsigned u32x2 __attribute__((ext_vector_type(2)));
                    u32x2 wa, wb; wa.x = cvt_pk_bf16(pa[0], pa[1]); wa.y = cvt_pk_bf16(pa[2], pa[3]); wb.x = cvt_pk_bf16(pb[0], pb[1]); wb.y = cvt_pk_bf16(pb[2], pb[3]);
                    *(u32x2*)(Q + (size_t)qrow * 2048 + ca_) = wa; *(u32x2*)(Q + (size_t)qrow * 2048 + cb_) = wb;
                }
            }
    }
};

struct SplitOrder {
    int nsub, G, c, pm; unsigned* cnt;
    __device__ __forceinline__ bool next(int i, Unit& u) const { const long L = (long)i * G + c; if (L >= nsub) return false; u.pm = pm; u.pn = (int)(L & 3); u.kofs = (int)(L >> 2) * 256; return true; }
    __device__ __forceinline__ void a_ready(const Unit&) const {}
    __device__ __forceinline__ void done(const Unit&) const {}
};
struct EpiPart {
    static constexpr bool PERM = true, AFTER_DRAIN = false;
    float* P;
    __device__ __forceinline__ void operator()(const f32x4 (&acc)[2][2][4][2], const Unit& u, int wr, int wc, int fr, int fq) const {
        float* base = P + (size_t)(u.kofs >> 8) * (256 * 1024) + (size_t)(wr * 64 + fr) * 1024 + u.pn * BM + wc * 32 + 8 * fq;
#pragma unroll
        for (int ai = 0; ai < 2; ++ai)
#pragma unroll
            for (int m = 0; m < 4; ++m) { float* rowp = base + (size_t)(ai * HALF + m * 16) * 1024;
#pragma unroll
                for (int bj = 0; bj < 2; ++bj) { *(f32x4*)(rowp + bj * HALF) = acc[ai][bj][m][0]; *(f32x4*)(rowp + bj * HALF + 4) = acc[ai][bj][m][1]; } }
    }
};

struct OneUnit {
    StaticOrder S; int round;
    __device__ __forceinline__ bool next(int i, Unit& u) const { return (i == 0) ? S.next(round, u) : false; }
    __device__ __forceinline__ void a_ready(const Unit&) const {}
    __device__ __forceinline__ void done(const Unit&) const {}
};
struct RmsStats {
    float* xbuf;
    unsigned* cnt;
    __device__ __forceinline__ void run(const f32x4 (&v)[2][2][4][2], const Unit& u, int wr, int wc, int fr, int fq, PG8_LAS unsigned char* lds, int wid, int lane) const {
        PG8_LAS float* P = (PG8_LAS float*)lds;
        PG8_LAS float* S = (PG8_LAS float*)(lds + 8192);
        const int a16 = ((lane ^ 16) << 2), a32 = ((lane ^ 32) << 2);
#pragma unroll
        for (int ai = 0; ai < 2; ++ai)
#pragma unroll
            for (int m = 0; m < 4; ++m) {
                float s = 0.f;
#pragma unroll
                for (int bj = 0; bj < 2; ++bj)
#pragma unroll
                    for (int n = 0; n < 2; ++n) { const f32x4 x = v[ai][bj][m][n]; s += (x[0] * x[0] + x[1] * x[1]) + (x[2] * x[2] + x[3] * x[3]); }
                s += __builtin_bit_cast(float, __builtin_amdgcn_ds_bpermute(a16, __builtin_bit_cast(int, s)));
                s += __builtin_bit_cast(float, __builtin_amdgcn_ds_bpermute(a32, __builtin_bit_cast(int, s)));
                if (fq == 0) P[(ai * HALF + wr * 64 + m * 16 + fr) * 4 + wc] = s;
            }
        asm volatile("s_waitcnt lgkmcnt(0)" ::: "memory"); __builtin_amdgcn_s_barrier(); asm volatile("" ::: "memory");
        const int row = wid * 32 + (lane & 31);
        if (lane < 32) { const float t = (P[row * 4 + 0] + P[row * 4 + 1]) + (P[row * 4 + 2] + P[row * 4 + 3]);
            __hip_atomic_store(xbuf + ((size_t)(u.pm * BM + row) * 4 + u.pn), t, __ATOMIC_RELAXED, __HIP_MEMORY_SCOPE_AGENT); }
        asm volatile("s_waitcnt vmcnt(0)" ::: "memory");
        if (lane == 0) __hip_atomic_fetch_add(cnt + 64 * u.pm, 1u, __ATOMIC_RELAXED, __HIP_MEMORY_SCOPE_AGENT);
        if (wid == 0) {
            unsigned spins = 0;
            while ((unsigned)__builtin_amdgcn_readfirstlane(__hip_atomic_load(cnt + 64 * u.pm, __ATOMIC_RELAXED, __HIP_MEMORY_SCOPE_AGENT)) < 32u) { __builtin_amdgcn_s_sleep(2); if (++spins > (1u << 24)) break; }
            __builtin_amdgcn_fence(__ATOMIC_ACQUIRE, "agent");
        }
        asm volatile("s_waitcnt vmcnt(0) lgkmcnt(0)" ::: "memory"); __builtin_amdgcn_s_barrier(); asm volatile("" ::: "memory");
        if (lane < 32) { const float* slot = xbuf + (size_t)(u.pm * BM + row) * 4; float t = 0.f;
#pragma unroll
            for (int k = 0; k < 4; ++k) t += __hip_atomic_load(slot + k, __ATOMIC_RELAXED, __HIP_MEMORY_SCOPE_AGENT);
            S[row] = t; }
        asm volatile("s_waitcnt vmcnt(0) lgkmcnt(0)" ::: "memory"); __builtin_amdgcn_s_barrier(); asm volatile("" ::: "memory");
    }
};
struct EpiRms2 {
    static constexpr bool PERM = false, AFTER_DRAIN = true;
    const void* base; int base_mode; const float* g_prev; const float* rstd_prev; float* out; bf16_t* xn; float* rstd_out; const float* ga; const float* gb; float scale; RmsStats st1, st2; const float* rsc;
    __device__ __forceinline__ void operator()(const f32x4 (&)[2][2][4][2], const Unit&, int, int, int, int) const {}
    __device__ __forceinline__ void kscale(f32x4 (&acc)[2][2][4][2], const Unit& u, int t, int wr, int fr) const {
        const int sel = (t == 6) ? 0 : ((t == 10) ? 1 : 2);
#pragma unroll
        for (int ai = 0; ai < 2; ++ai)
#pragma unroll
            for (int m = 0; m < 4; ++m) { const float f = rsc[(size_t)(u.pm * BM + ai * HALF + wr * 64 + m * 16 + fr) * 4 + sel];
#pragma unroll
                for (int bj = 0; bj < 2; ++bj)
#pragma unroll
                    for (int n = 0; n < 2; ++n) acc[ai][bj][m][n] = acc[ai][bj][m][n] * f; }
    }
    __device__ __forceinline__ void fused(f32x4 (&acc)[2][2][4][2], const Unit& u, int wr, int wc, int fr, int fq, PG8_LAS unsigned char* lds, int wid, int lane) const {
        typedef unsigned u32x2v __attribute__((ext_vector_type(2)));
        const PG8_LAS float* S = (const PG8_LAS float*)(lds + 8192);
        const int col0 = u.pn * BM + wc * 32 + 4 * fq;
        if (rsc) kscale(acc, u, -1, wr, fr);
        st1.run(acc, u, wr, wc, fr, fq, lds, wid, lane);
#pragma unroll
        for (int ai = 0; ai < 2; ++ai)
#pragma unroll
            for (int m = 0; m < 4; ++m) { const int r = ai * HALF + wr * 64 + m * 16 + fr; const float rs = scale * __builtin_amdgcn_rsqf(S[r] * (1.0f / 1024.0f) + 1e-6f); const size_t off = (size_t)(u.pm * BM + r) * 1024 + col0;
                const float binv = base_mode ? __builtin_amdgcn_rcpf(rstd_prev[u.pm * BM + r]) : 1.f;
#pragma unroll
                for (int bj = 0; bj < 2; ++bj)
#pragma unroll
                    for (int n = 0; n < 2; ++n) { f32x4 bs;
                        if (base_mode) { const u32x2v w = *(const u32x2v*)((const bf16_t*)base + off + bj * HALF + n * 16); const f32x4 gp = *(const f32x4*)(g_prev + col0 + bj * HALF + n * 16);
                            bs = (f32x4){__builtin_bit_cast(float, w.x << 16) * __builtin_amdgcn_rcpf(gp[0]), __builtin_bit_cast(float, w.x & 0xffff0000u) * __builtin_amdgcn_rcpf(gp[1]),
                                         __builtin_bit_cast(float, w.y << 16) * __builtin_amdgcn_rcpf(gp[2]), __builtin_bit_cast(float, w.y & 0xffff0000u) * __builtin_amdgcn_rcpf(gp[3])} * binv; }
                        else bs = *(const f32x4*)((const float*)base + off + bj * HALF + n * 16);
                        const f32x4 g = *(const f32x4*)(ga + col0 + bj * HALF + n * 16); acc[ai][bj][m][n] = bs + acc[ai][bj][m][n] * g * rs; }
                asm volatile("" : "+v"(acc[ai][0][m][0]), "+v"(acc[ai][0][m][1]), "+v"(acc[ai][1][m][0]), "+v"(acc[ai][1][m][1]));
                if (m & 1) asm volatile("" ::: "memory"); }
        if (gb) st2.run(acc, u, wr, wc, fr, fq, lds, wid, lane);
#pragma unroll
        for (int ai = 0; ai < 2; ++ai)
#pragma unroll
            for (int m = 0; m < 4; ++m) { const int r = ai * HALF + wr * 64 + m * 16 + fr; const size_t off = (size_t)(u.pm * BM + r) * 1024 + col0;
                const float rs2 = gb ? __builtin_amdgcn_rsqf(S[r] * (1.0f / 1024.0f) + 1e-6f) : 0.f;
                if (gb && u.pn == 0 && wc == 0 && fq == 0) rstd_out[u.pm * BM + r] = rs2;
#pragma unroll
                for (int bj = 0; bj < 2; ++bj)
#pragma unroll
                    for (int n = 0; n < 2; ++n) { const f32x4 x1 = acc[ai][bj][m][n];
                        if (out) *(f32x4*)(out + off + bj * HALF + n * 16) = x1;
                        if (gb) { const f32x4 g = *(const f32x4*)(gb + col0 + bj * HALF + n * 16); const f32x4 o = x1 * g * rs2; u32x2v w; w.x = cvt_pk_bf16(o[0], o[1]); w.y = cvt_pk_bf16(o[2], o[3]); *(u32x2v*)(xn + off + bj * HALF + n * 16) = w; } }
                asm volatile("" ::: "memory"); }
    }
};
template <class Epi, class Sched, bool ALIGN_EPI = false, bool SP2 = false, bool KSCALE = false>
__device__ __forceinline__ void gemm_phase(PG8_LAS unsigned char* lds, const Gemm g, const Sched& S, const Epi& E, int tid_in) {
    int tid_ = tid_in; asm volatile("" : "+v"(tid_));
    const int tid = tid_, wid = __builtin_amdgcn_readfirstlane(tid >> 6), lane = tid & 63, wr = wid >> 2, wc = wid & 3, fr = lane & 15, fq = lane >> 4;
    const int K = g.ld, nt = g.K / BK;
    unsigned voffA[2], voffB[2];
#pragma unroll
    for (int i = 0; i < 2; ++i) { int R, C; stage_rc(tid * 16 + i * 8192, R, C); const int Rb = Epi::PERM ? ((R & ~31) + perm32(R & 31)) : R;
        voffA[i] = (unsigned)(R * K + C) * 2u; voffB[i] = (unsigned)(Rb * K + C) * 2u; }
    const size_t kstep = (size_t)(BK * 2);
    const size_t hstep = (size_t)HALF * K * 2;
    const size_t tstep = 2 * hstep;
    const unsigned ldsw = (unsigned)wid * 1024u;
    const int aoff = lds_byte(wr * 64 + fr, fq * 8), boff = lds_byte(wc * 32 + fr, fq * 8);
#define PG8_SA(b, h) (((b) * 2 + (h)) * HTB)
#define PG8_SB(b, h) ((4 + (b) * 2 + (h)) * HTB)
#define PG8_STAGE(bufoff, gbase, voff) do { _Pragma("unroll") for (int _i = 0; _i < 2; ++_i) \
        __builtin_amdgcn_global_load_lds((const unsigned*)((const char*)(gbase) + (voff)[_i]), (PG8_LAS unsigned*)(lds + (bufoff) + ldsw + _i * 8192), 16, 0, 0); } while (0)
#define PG8_LDA(dst, b, h) do { _Pragma("unroll") for (int m = 0; m < 4; ++m) _Pragma("unroll") for (int k = 0; k < 2; ++k) dst[m][k] = *(const PG8_LAS bf16x8*)(lds + PG8_SA(b, h) + aoff + m * 2048 + k * 1024); } while (0)
#define PG8_LDB(dst, b, h) do { _Pragma("unroll") for (int n = 0; n < 2; ++n) _Pragma("unroll") for (int k = 0; k < 2; ++k) dst[n][k] = *(const PG8_LAS bf16x8*)(lds + PG8_SB(b, h) + boff + n * 2048 + k * 1024); } while (0)
#define PG8_MMA(ai, bj, At, Bt) do { __builtin_amdgcn_s_setprio(1); _Pragma("unroll") for (int m = 0; m < 4; ++m) _Pragma("unroll") for (int n = 0; n < 2; ++n) _Pragma("unroll") for (int k = 0; k < 2; ++k) \
        acc[ai][bj][m][n] = __builtin_amdgcn_mfma_f32_16x16x32_bf16(Bt[n][k], At[m][k], acc[ai][bj][m][n], 0, 0, 0); __builtin_amdgcn_s_setprio(0); } while (0)
#define PG8_WAIT_V(n) asm volatile("s_waitcnt vmcnt(" #n ")" ::: "memory")
#define PG8_WAIT_L(n) asm volatile("s_waitcnt lgkmcnt(" #n ")" ::: "memory")
#define PG8_BAR __builtin_amdgcn_s_barrier()
#define PG8_SCHED __builtin_amdgcn_sched_barrier(0)
    Unit cur, nxt; int ui = 0;
    if (!S.next(0, cur)) return;
    f32x4 acc[2][2][4][2];
#pragma unroll
    for (int a = 0; a < 2; ++a)
#pragma unroll
        for (int b = 0; b < 2; ++b)
#pragma unroll
            for (int m = 0; m < 4; ++m)
#pragma unroll
                for (int n = 0; n < 2; ++n) acc[a][b][m][n] = (f32x4){0.f, 0.f, 0.f, 0.f};
    bf16x8 At[4][2], B0[2][2], B1[2][2];
    const char* cA = (const char*)g.A + (size_t)cur.pm * tstep + (size_t)cur.kofs * 2; const char* cB = (const char*)g.Bt + (size_t)cur.pn * tstep + (size_t)cur.kofs * 2;
    S.a_ready(cur);
    if constexpr (SP2) {
        PG8_STAGE(PG8_SB(0, 0), cB, voffB); PG8_STAGE(PG8_SB(0, 1), cB + hstep, voffB); PG8_STAGE(PG8_SA(0, 0), cA, voffA); PG8_STAGE(PG8_SA(0, 1), cA + hstep, voffA);
        if (wr == 1) PG8_BAR;
        PG8_WAIT_V(2); PG8_BAR;
        PG8_STAGE(PG8_SB(1, 0), cB + kstep, voffB); PG8_STAGE(PG8_SA(1, 0), cA + kstep, voffA); PG8_STAGE(PG8_SB(1, 1), cB + hstep + kstep, voffB);
        PG8_WAIT_V(6); PG8_BAR;
    } else {
        PG8_STAGE(PG8_SB(0, 0), cB, voffB); PG8_STAGE(PG8_SA(0, 0), cA, voffA); PG8_STAGE(PG8_SB(0, 1), cB + hstep, voffB); PG8_STAGE(PG8_SA(0, 1), cA + hstep, voffA);
        if (wr == 1) PG8_BAR;
        PG8_WAIT_V(4); PG8_BAR;
        PG8_STAGE(PG8_SB(1, 0), cB + kstep, voffB); PG8_STAGE(PG8_SA(1, 0), cA + kstep, voffA); PG8_STAGE(PG8_SB(1, 1), cB + hstep + kstep, voffB);
        PG8_WAIT_V(6); PG8_BAR;
    }
    for (;;) {
        const bool has_next = S.next(ui + 1, nxt);
        const char* nA = has_next ? (const char*)g.A + (size_t)nxt.pm * tstep + (size_t)nxt.kofs * 2 : cA; const char* nB = has_next ? (const char*)g.Bt + (size_t)nxt.pn * tstep + (size_t)nxt.kofs * 2 : cB;
        for (int t = 0; t < nt; t += 2) {
            const bool last = (t == nt - 2);
            const char* a1 = cA + (size_t)(t + 1) * kstep;
            const char* a2 = last ? nA : cA + (size_t)(t + 2) * kstep; const char* b2 = last ? nB : cB + (size_t)(t + 2) * kstep;
            const char* a3 = a2 + kstep; const char* b3 = b2 + kstep;
            if (last && has_next) S.a_ready(nxt);
            if constexpr (KSCALE) { if (t == 6 || t == 10) E.kscale(acc, cur, t, wr, fr); }
            if constexpr (SP2) {
            PG8_LDB(B0, 0, 0); PG8_LDB(B1, 0, 1); PG8_SCHED; PG8_LDA(At, 0, 0); PG8_STAGE(PG8_SA(1, 1), a1 + hstep, voffA);
            PG8_WAIT_V(8); PG8_WAIT_L(0); PG8_BAR; PG8_MMA(0, 0, At, B0); PG8_MMA(0, 1, At, B1); PG8_BAR; PG8_SCHED;
            PG8_LDA(At, 0, 1); PG8_STAGE(PG8_SB(0, 0), b2, voffB); PG8_STAGE(PG8_SB(0, 1), b2 + hstep, voffB); PG8_STAGE(PG8_SA(0, 0), a2, voffA);
            PG8_WAIT_V(8); PG8_WAIT_L(0); PG8_BAR; PG8_MMA(1, 0, At, B0); PG8_MMA(1, 1, At, B1); PG8_BAR; PG8_SCHED;
            PG8_LDB(B0, 1, 0); PG8_LDB(B1, 1, 1); PG8_SCHED; PG8_LDA(At, 1, 0); PG8_STAGE(PG8_SA(0, 1), a2 + hstep, voffA);
            PG8_WAIT_V(8); PG8_WAIT_L(0); PG8_BAR; PG8_MMA(0, 0, At, B0); PG8_MMA(0, 1, At, B1); PG8_BAR; PG8_SCHED;
            PG8_LDA(At, 1, 1); PG8_STAGE(PG8_SB(1, 0), b3, voffB); PG8_STAGE(PG8_SB(1, 1), b3 + hstep, voffB); PG8_STAGE(PG8_SA(1, 0), a3, voffA);
            PG8_WAIT_V(8); PG8_WAIT_L(0); PG8_BAR; PG8_MMA(1, 0, At, B0); PG8_MMA(1, 1, At, B1); PG8_BAR; PG8_SCHED;
            } else {
            PG8_LDB(B0, 0, 0); PG8_SCHED; PG8_LDA(At, 0, 0); PG8_STAGE(PG8_SA(1, 1), a1 + hstep, voffA);
            PG8_WAIT_L(8); PG8_BAR; PG8_WAIT_L(0); PG8_MMA(0, 0, At, B0); PG8_BAR; PG8_SCHED;
            PG8_LDB(B1, 0, 1); PG8_STAGE(PG8_SB(0, 0), b2, voffB);
            PG8_BAR; PG8_WAIT_L(0); PG8_MMA(0, 1, At, B1); PG8_BAR;
            PG8_LDA(At, 0, 1); PG8_STAGE(PG8_SA(0, 0), a2, voffA);
            PG8_BAR; PG8_WAIT_L(0); PG8_MMA(1, 0, At, B0); PG8_BAR; PG8_SCHED;
            PG8_STAGE(PG8_SB(0, 1), b2 + hstep, voffB);
            PG8_WAIT_V(6); PG8_BAR; PG8_MMA(1, 1, At, B1); PG8_BAR;
            PG8_LDB(B0, 1, 0); PG8_SCHED; PG8_LDA(At, 1, 0); PG8_STAGE(PG8_SA(0, 1), a2 + hstep, voffA);
            PG8_WAIT_L(8); PG8_BAR; PG8_WAIT_L(0); PG8_MMA(0, 0, At, B0); PG8_BAR; PG8_SCHED;
            PG8_LDB(B1, 1, 1); PG8_STAGE(PG8_SB(1, 0), b3, voffB);
            PG8_BAR; PG8_WAIT_L(0); PG8_MMA(0, 1, At, B1); PG8_BAR;
            PG8_LDA(At, 1, 1); PG8_STAGE(PG8_SA(1, 0), a3, voffA);
            PG8_BAR; PG8_WAIT_L(0); PG8_MMA(1, 0, At, B0); PG8_BAR; PG8_SCHED;
            PG8_STAGE(PG8_SB(1, 1), b3 + hstep, voffB);
            PG8_WAIT_V(6); PG8_BAR; PG8_MMA(1, 1, At, B1); PG8_BAR;
            }
        }
        if constexpr (ALIGN_EPI) { if (wr == 0) PG8_BAR; }
        if constexpr (!Epi::AFTER_DRAIN) { E(acc, cur, wr, wc, fr, fq); S.done(cur); }
        if (!has_next) break;
#pragma unroll
        for (int a = 0; a < 2; ++a)
#pragma unroll
            for (int b = 0; b < 2; ++b)
#pragma unroll
                for (int m = 0; m < 4; ++m)
#pragma unroll
                    for (int n = 0; n < 2; ++n) acc[a][b][m][n] = (f32x4){0.f, 0.f, 0.f, 0.f};
        cur = nxt; cA = nA; cB = nB; ++ui;
        if constexpr (ALIGN_EPI) { if (wr == 1) PG8_BAR; }
    }
    PG8_WAIT_V(0);
    if constexpr (!ALIGN_EPI) { if (wr == 0) PG8_BAR; }
    PG8_BAR;
    if constexpr (Epi::AFTER_DRAIN) { E.fused(acc, cur, wr, wc, fr, fq, lds, wid, lane); S.done(cur); }
#undef PG8_SA
#undef PG8_SB
#undef PG8_STAGE
#undef PG8_LDA
#undef PG8_LDB
#undef PG8_MMA
#undef PG8_WAIT_V
#undef PG8_WAIT_L
#undef PG8_BAR
#undef PG8_SCHED
}
}

#ifndef PHMASK
#define PHMASK 0xffffffffu
#endif
constexpr unsigned PHM = PHMASK;
constexpr int NWAVES = 8, NTHREADS = 512;
constexpr int DM = 1024, TP = 32768, TS = 256, TT = TP + TS;
constexpr int DFF = 2816, DIN = 2048;
constexpr int QROWS = TP + 8 * 544;
constexpr float EPSN = 1e-6f, LOG2E = 1.4426950408889634f;
constexpr size_t O_YP = 0, O_YS = 33554432, O_AKP = 33816576, O_AVP = 35389440, O_CKP = 36962304, O_CVP = 37093376, O_SRP = 37224448, O_SIP = 37232640,
                 O_AKS = 37240832, O_AVS = 40386560, O_CKS = 43532288, O_CVS = 43794432, O_SRS = 44056576, O_SIS = 44072960;
constexpr size_t MiB = 1u << 20;
constexpr size_t WS_ROPE = 0, WS_LAM = 1 * MiB, WS_L64 = WS_LAM + 32768, WS_BBB = WS_L64 + 32768, WS_CCB = WS_BBB + 524288;
constexpr size_t WS_SSH = 2 * MiB, WS_SLOC = 5 * MiB;
constexpr size_t WS_WUP = 10 * MiB, WS_WDN = 54 * MiB, WS_WIN = 76 * MiB, WS_WOUT = 84 * MiB, WS_WGLU = 88 * MiB;
constexpr size_t WS_XN = 89 * MiB, WS_OUT = 154 * MiB, WS_MIX = 219 * MiB, WS_YB = 284 * MiB, WS_ACT = 301 * MiB, WS_QKV = WS_ACT, WS_PART = 480 * MiB, WS_XBUF = 492 * MiB, WS_SSB = 498 * MiB, WS_RS = WS_SSB + 1536 * 1024, WS_RSTD = WS_RS + 768 * 1024, WS_END = 501 * MiB;
static_assert(WS_CCB + 131072 <= WS_SSH && WS_SSH + (size_t)TT * 16 * 4 <= WS_SLOC && WS_SLOC + 4 * MiB <= WS_WUP, "ws small region");
static_assert(WS_ACT + (size_t)TT * DFF * 2 <= WS_END && WS_QKV + (size_t)(QROWS + 64) * DIN * 2 <= WS_END, "ws big region");
constexpr int LDS_BYTES = 147456, WAVE_LDS = 17408, TAB_OFF = NWAVES * WAVE_LDS;

#define GAS __attribute__((address_space(1)))
#define LAS __attribute__((address_space(3)))
typedef unsigned short bf16;
typedef unsigned v4u __attribute__((ext_vector_type(4)));
typedef unsigned v2u __attribute__((ext_vector_type(2)));
typedef float f32x4 __attribute__((ext_vector_type(4)));
typedef float f32x2 __attribute__((ext_vector_type(2)));
typedef short bf16x8 __attribute__((ext_vector_type(8)));
typedef short s16x4 __attribute__((ext_vector_type(4)));
typedef short v4i16_t __attribute__((ext_vector_type(4)));
#define LDS_WAIT() asm volatile("s_waitcnt lgkmcnt(0)" ::: "memory")
#define CFENCE() asm volatile("" ::: "memory")
__device__ __forceinline__ unsigned f2bf(float f) { unsigned u = __builtin_bit_cast(unsigned, f); return (u + 0x7fffu + ((u >> 16) & 1u)) >> 16; }
typedef __bf16 bf16x2_t __attribute__((ext_vector_type(2)));
__device__ __forceinline__ unsigned pk2(float lo, float hi) { const f32x2 v = {lo, hi}; const bf16x2_t b = __builtin_convertvector(v, bf16x2_t); return __builtin_bit_cast(unsigned, b); }
__device__ __forceinline__ float bflo(unsigned w) { return __builtin_bit_cast(float, w << 16); }
__device__ __forceinline__ float bfhi(unsigned w) { return __builtin_bit_cast(float, w & 0xffff0000u); }
__device__ __forceinline__ float shx(float v, int mask, int lane) { return __builtin_bit_cast(float, __builtin_amdgcn_ds_bpermute((lane ^ mask) << 2, __builtin_bit_cast(int, v))); }
__device__ __forceinline__ float wave_sum(float v, int lane) {
#pragma unroll
    for (int o = 1; o < 64; o <<= 1) v += shx(v, o, lane);
    return v;
}
__device__ __forceinline__ s16x4 vtr(const LAS unsigned char* p) { return __builtin_bit_cast(s16x4, __builtin_amdgcn_ds_read_tr16_b64_v4i16((LAS v4i16_t*)p)); }

struct Args { const float* in[25]; float* out; unsigned char* ws; int ph_lo, ph_hi, li, pad; };

#define XB_TMO      128
#define XB_XCNT(j)  (256  + 64 * (j))
#define XB_XSUB(j)  (1280 + 64 * (j))
#define XB_XGEN(j)  (2304 + 64 * (j))
#define XB_TOP      3328
#define XB_TOPGEN   3392
#define XCD_BAR_WORDS 4096
#define XB_SPIN_CAP (1u << 22)
__device__ __forceinline__ unsigned xb_ld(unsigned* p)              { return __hip_atomic_load(p, __ATOMIC_RELAXED, __HIP_MEMORY_SCOPE_AGENT); }
__device__ __forceinline__ unsigned xb_add(unsigned* p, unsigned v) { return __hip_atomic_fetch_add(p, v, __ATOMIC_RELAXED, __HIP_MEMORY_SCOPE_AGENT); }
__device__ __forceinline__ unsigned xb_xcc_id() { return (unsigned)__builtin_amdgcn_s_getreg((3 << 11) | 20) & 0xFu; }
#define XB_SPIN(cond, bar) do { unsigned _sp = 0; while (cond) { __builtin_amdgcn_s_sleep(1); \
    if ((++_sp & 255u) == 0u) { if (xb_ld(&(bar)[XB_TMO])) break; if (_sp > XB_SPIN_CAP) { atomicAdd(&(bar)[XB_TMO], 1u); break; } } } } while (0)
__device__ __forceinline__ void xcd_barrier_complete(unsigned* bar, unsigned x, unsigned G, unsigned& nloc, unsigned& nx) {
    unsigned sum, cnt, mine, sp = 0u;
    for (;;) {
        sum = 0u; cnt = 0u; mine = 0u;
#pragma unroll
        for (unsigned j = 0; j < 16; ++j) { const unsigned c = xb_ld(&bar[XB_XCNT(j)]); sum += c; cnt += (c > 0u) ? 1u : 0u; mine = (j == x) ? c : mine; }
        if (sum == G) break;
        __builtin_amdgcn_s_sleep(1);
        if ((++sp & 255u) == 0u) { if (xb_ld(&bar[XB_TMO])) break; if (sp > XB_SPIN_CAP) { atomicAdd(&bar[XB_TMO], 1u); break; } }
    }
    nloc = mine > 0u ? mine : 1u; nx = cnt > 0u ? cnt : 1u;
}
__device__ __forceinline__ void xcd_barrier(unsigned* bar, unsigned x, unsigned G, volatile LAS unsigned* st, int tid) {
    asm volatile("s_waitcnt vmcnt(0) lgkmcnt(0)" ::: "memory");
    __syncthreads();
    if (tid == 0) {
        __builtin_amdgcn_s_waitcnt(0);
        unsigned nloc = st[0], nx = st[1];
        if (nloc == 0u) { xcd_barrier_complete(bar, x, G, nloc, nx); st[0] = nloc; st[1] = nx; }
        const unsigned old = xb_add(&bar[XB_XSUB(x)], 1u);
        const unsigned gen = old / nloc;
        if (old + 1u == (gen + 1u) * nloc) {
            __builtin_amdgcn_fence(__ATOMIC_RELEASE, "agent");
            asm volatile("s_waitcnt vmcnt(0)" ::: "memory");
            const unsigned og = xb_add(&bar[XB_TOP], 1u);
            const unsigned tg = og / nx;
            if (og + 1u == (tg + 1u) * nx) xb_add(&bar[XB_TOPGEN], 1u);
            else XB_SPIN(xb_ld(&bar[XB_TOPGEN]) == tg, bar);
            __builtin_amdgcn_fence(__ATOMIC_ACQUIRE, "agent");
            xb_add(&bar[XB_XGEN(x)], 1u);
            asm volatile("s_waitcnt vmcnt(0)" ::: "memory");
        } else {
            XB_SPIN(xb_ld(&bar[XB_XGEN(x)]) == gen, bar);
            __builtin_amdgcn_fence(__ATOMIC_ACQUIRE, "agent");
            asm volatile("s_waitcnt vmcnt(0)" ::: "memory");
        }
    }
    __syncthreads();
}
__device__ __forceinline__ int lane_id_v() { int r; asm volatile("v_mbcnt_lo_u32_b32 %0, -1, 0\n\tv_mbcnt_hi_u32_b32 %0, -1, %0" : "=v"(r)); return r; }
constexpr size_t WS_CTL = 9 * MiB, WS_PCNT = WS_CTL + 131072;
__device__ __forceinline__ void gbar(unsigned* ctr, unsigned target, int tid) {
    asm volatile("s_waitcnt vmcnt(0) lgkmcnt(0)" ::: "memory");
    __syncthreads();
    if (tid == 0) {
        __builtin_amdgcn_fence(__ATOMIC_RELEASE, "agent");
        asm volatile("s_waitcnt vmcnt(0)" ::: "memory");
        __hip_atomic_fetch_add(ctr, 1u, __ATOMIC_RELAXED, __HIP_MEMORY_SCOPE_AGENT);
        while (__hip_atomic_load(ctr, __ATOMIC_RELAXED, __HIP_MEMORY_SCOPE_AGENT) < target) __builtin_amdgcn_s_sleep(2);
        __builtin_amdgcn_fence(__ATOMIC_ACQUIRE, "agent");
        asm volatile("s_waitcnt vmcnt(0)" ::: "memory");
    }
    __syncthreads();
}
constexpr int PTAB_OFF = LDS_BYTES - 512;
__device__ __forceinline__ const float* inptr(LAS unsigned char* lds, int k) { const LAS unsigned* t = (const LAS unsigned*)(lds + PTAB_OFF) + 2 * k;
    const unsigned lo = __builtin_amdgcn_readfirstlane(t[0]), hi = __builtin_amdgcn_readfirstlane(t[1]); return (const float*)(((unsigned long long)hi << 32) | lo); }

__device__ __forceinline__ void transpose_item(const float* __restrict__ W, int K, int N, bf16* WT, int dst_row0, int k0, int n0, const float* kscale, LAS float* scr, int lane, bool ropeperm = false) {
#pragma unroll
    for (int i = 0; i < 8; ++i) { const int kk = 8 * i + (lane >> 3), n4 = (lane & 7) * 4; f32x4 v = *(const f32x4*)(W + (size_t)(k0 + kk) * N + n0 + n4); if (kscale) v = v * kscale[k0 + kk];
        scr[kk * 33 + n4] = v.x; scr[kk * 33 + n4 + 1] = v.y; scr[kk * 33 + n4 + 2] = v.z; scr[kk * 33 + n4 + 3] = v.w; }
    LDS_WAIT();
    const int c = lane & 7;
#pragma unroll
    for (int j = 0; j < 4; ++j) { const int n = (lane >> 3) + 8 * j; const LAS float* s = scr + (8 * c) * 33 + n;
        const int nd = (ropeperm && n < 16) ? (8 * ((n >> 2) & 1) + 2 * (n & 3) + ((n >> 3) & 1)) : n;
        v4u o; o.x = pk2(s[0 * 33], s[1 * 33]); o.y = pk2(s[2 * 33], s[3 * 33]); o.z = pk2(s[4 * 33], s[5 * 33]); o.w = pk2(s[6 * 33], s[7 * 33]);
        *(v4u*)(WT + (size_t)(dst_row0 + nd) * K + k0 + 8 * c) = o; }
    LDS_WAIT();
}
__device__ __forceinline__ int glu_row(int n0, int half) { const int j = (n0 < half) ? n0 : n0 - half; return (j >> 7) * 256 + (j & 127) + ((n0 < half) ? 0 : 128); }

struct RowIn { f32x4 v[4]; f32x4 o[4]; };
__device__ __forceinline__ void row_load(RowIn& r, const float* xin, const bf16* OUT, int lane, const float* part, int nks) {
#pragma unroll
    for (int j = 0; j < 4; ++j) r.v[j] = ((const f32x4*)xin)[lane + 64 * j];
    if (OUT) {
#pragma unroll
        for (int j = 0; j < 4; ++j) { if (part) { f32x4 a0 = (f32x4){0.f, 0.f, 0.f, 0.f}, a1 = a0, a2 = a0, a3 = a0; int ks = 0;
                for (; ks + 4 <= nks; ks += 4) { const f32x4* pp = (const f32x4*)(part + (size_t)ks * 262144) + lane + 64 * j; const f32x4 b0 = pp[0], b1 = pp[65536], b2 = pp[131072], b3 = pp[196608]; a0 = a0 + b0; a1 = a1 + b1; a2 = a2 + b2; a3 = a3 + b3; }
                for (; ks < nks; ++ks) a0 = a0 + ((const f32x4*)(part + (size_t)ks * 262144))[lane + 64 * j];
                r.o[j] = (a0 + a1) + (a2 + a3); }
            else { const v2u w = ((const v2u*)OUT)[lane + 64 * j]; r.o[j] = (f32x4){bflo(w.x), bfhi(w.x), bflo(w.y), bfhi(w.y)}; } }
    }
}
__device__ __forceinline__ void row_finish(RowIn& r, float* X, bool has_out, const float* ga, float scale, bf16* XN, const float* gb, int lane) {
    if (has_out) {
        float s = 0.f;
#pragma unroll
        for (int j = 0; j < 4; ++j) s += (r.o[j].x * r.o[j].x + r.o[j].y * r.o[j].y) + (r.o[j].z * r.o[j].z + r.o[j].w * r.o[j].w);
        const float rs = scale * __builtin_amdgcn_rsqf(wave_sum(s, lane) * (1.f / DM) + EPSN);
#pragma unroll
        for (int j = 0; j < 4; ++j) { const f32x4 g = ((const f32x4*)ga)[lane + 64 * j]; r.v[j] = r.v[j] + r.o[j] * g * rs; }
    }
    if (X) {
#pragma unroll
        for (int j = 0; j < 4; ++j) ((f32x4*)X)[lane + 64 * j] = r.v[j]; }
    if (gb) {
        float s = 0.f;
#pragma unroll
        for (int j = 0; j < 4; ++j) s += (r.v[j].x * r.v[j].x + r.v[j].y * r.v[j].y) + (r.v[j].z * r.v[j].z + r.v[j].w * r.v[j].w);
        const float rs = __builtin_amdgcn_rsqf(wave_sum(s, lane) * (1.f / DM) + EPSN);
#pragma unroll
        for (int j = 0; j < 4; ++j) { const f32x4 g = ((const f32x4*)gb)[lane + 64 * j]; const f32x4 y = r.v[j] * g * rs; v2u w; w.x = pk2(y.x, y.y); w.y = pk2(y.z, y.w); ((v2u*)XN)[lane + 64 * j] = w; }
    }
}
__device__ __forceinline__ void row_pass(const float* xin, float* X, const bf16* OUT, const float* ga, float scale, bf16* XN, const float* gb, int lane, const float* part = nullptr, int nks = 0) {
    RowIn r; row_load(r, xin, OUT, lane, part, nks); row_finish(r, X, OUT != nullptr, ga, scale, XN, gb, lane);
}
__device__ __forceinline__ void post_rows(const float* xbase  , const float* x_p_, const float* x_s_, float* X, const bf16* OUTB_, const float* partbase, int nks, const float* ga, float scale, bf16* XN_, const float* gb, int gw, int NGW, int lane, int mmin = 0) {
    for (int m0 = TT - 1 - gw; m0 >= mmin; m0 -= 4 * NGW) {
        RowIn r[4];
#pragma unroll
        for (int q = 0; q < 4; ++q) { const int m = m0 - q * NGW; if (m >= mmin) {
            const float* xin = xbase ? xbase + (size_t)m * DM : ((m < TP) ? x_p_ + (size_t)m * DM : x_s_ + (size_t)(m - TP) * DM);
            row_load(r[q], xin, OUTB_ + (size_t)m * DM, lane, (m >= TP) ? partbase + (size_t)(m - TP) * DM : nullptr, nks); } }
#pragma unroll
        for (int q = 0; q < 4; ++q) { const int m = m0 - q * NGW; if (m >= mmin) row_finish(r[q], X + (size_t)m * DM, true, ga, scale, XN_ ? XN_ + (size_t)m * DM : nullptr, gb, lane); }
    }
}

struct MixIn { v4u w0, w1; f32x4 s0, s1, s2; };
__device__ __forceinline__ void mix_load(MixIn& r, const float* SSHp, const bf16* MIXp, int m, int lane) {
    const f32x4* sp = (const f32x4*)(SSHp + (size_t)m * 16); r.s0 = sp[0]; r.s1 = sp[1]; r.s2 = sp[2];
    const v4u* mp = (const v4u*)(MIXp + (size_t)m * DM); r.w0 = mp[lane]; r.w1 = mp[lane + 64];
}
__device__ __forceinline__ v4u mix_scale(v4u x, float r) { x.x = pk2(bflo(x.x) * r, bfhi(x.x) * r); x.y = pk2(bflo(x.y) * r, bfhi(x.y) * r); x.z = pk2(bflo(x.z) * r, bfhi(x.z) * r); x.w = pk2(bflo(x.w) * r, bfhi(x.w) * r); return x; }
__device__ __forceinline__ float mix_ss(v4u x) { const float a0 = bflo(x.x), a1 = bfhi(x.x), a2 = bflo(x.y), a3 = bfhi(x.y), a4 = bflo(x.z), a5 = bfhi(x.z), a6 = bflo(x.w), a7 = bfhi(x.w);
    return (a0 * a0 + a1 * a1) + (a2 * a2 + a3 * a3) + (a4 * a4 + a5 * a5) + (a6 * a6 + a7 * a7); }
__device__ __forceinline__ void mix_finish(const MixIn& r, bf16* MIXp, int m, bool valid, int lane) {
    const float ra = __builtin_amdgcn_rsqf(((r.s0.x + r.s0.y) + (r.s0.z + r.s0.w) + (r.s1.x + r.s1.y)) * (1.f / 384.f) + EPSN);
    const float rc = __builtin_amdgcn_rsqf(((r.s1.z + r.s1.w) + (r.s2.x + r.s2.y) + (r.s2.z + r.s2.w)) * (1.f / 384.f) + EPSN);
    float sb = 0.f;
    if (lane >= 48) sb += mix_ss(r.w0);
    if (lane < 16) sb += mix_ss(r.w1);
    const float rb = __builtin_amdgcn_rsqf(wave_sum(sb, lane) * (1.f / 256.f) + EPSN);
    v4u* mp = (v4u*)(MIXp + (size_t)m * DM);
    if (valid) { mp[lane] = mix_scale(r.w0, (lane < 48) ? ra : rb); mp[lane + 64] = mix_scale(r.w1, (lane < 16) ? rb : rc); }
}

__device__ __forceinline__ void sample_rows_after_split(unsigned* cnt, int nsub, int bid, int tid, const float* xin_base, float* X, const float* part, int nks, const float* ga, float scale, bf16* XN_, const float* gb) {
    const int lane = tid & 63, wave = __builtin_amdgcn_readfirstlane(tid >> 6);
    if (bid < nsub) {
        asm volatile("s_waitcnt vmcnt(0)" ::: "memory"); __syncthreads();
        if (tid == 0) { __builtin_amdgcn_fence(__ATOMIC_RELEASE, "agent"); asm volatile("s_waitcnt vmcnt(0)" ::: "memory"); __hip_atomic_fetch_add(cnt, 1u, __ATOMIC_RELAXED, __HIP_MEMORY_SCOPE_AGENT); }
        return;
    }
    if (bid < 224) return;
    if (tid == 0) { unsigned spins = 0;
        while (__hip_atomic_load(cnt, __ATOMIC_RELAXED, __HIP_MEMORY_SCOPE_AGENT) < (unsigned)nsub) { __builtin_amdgcn_s_sleep(16); if (++spins > (1u << 22)) break; }
        __builtin_amdgcn_fence(__ATOMIC_ACQUIRE, "agent"); asm volatile("s_waitcnt vmcnt(0)" ::: "memory"); }
    __syncthreads();
    const int r = (bid - 224) * 8 + wave, m = TP + r;
    RowIn a; row_load(a, xin_base + (size_t)r * DM, (const bf16*)part  , lane, part + (size_t)r * DM, nks);
    row_finish(a, X + (size_t)m * DM, true, ga, scale, XN_ ? XN_ + (size_t)m * DM : nullptr, gb, lane);
}

template <int NQB> __device__ __forceinline__ void attn_unit(const bf16* QKV, bf16* MIX, float* SSH, LAS unsigned char* wl, const LAS float* tab, bool has_bias,
                                          int srow0, int qpos0, int kt0, int kend, int qcol, int kcol, int vcol, int ocol, int sidx, int mixrow0, float m_init, bool has_sink, int lane) {
    const int fr = lane & 15, fq = lane >> 4; constexpr int nqb = NQB, nq = 16 * NQB;
    bf16x8 qf[NQB][2];
#pragma unroll
    for (int qb = 0; qb < NQB; ++qb) { int qr = 16 * qb + fr; qr = qr < nq ? qr : nq - 1; const bf16* qp = QKV + (size_t)(srow0 + qpos0 + qr) * DIN + qcol + 8 * fq;
        qf[qb][0] = *(const bf16x8*)qp; qf[qb][1] = *(const bf16x8*)(qp + 32); }
    f32x4 o[NQB][4]; float mrun[NQB], lrun[NQB];
#pragma unroll
    for (int qb = 0; qb < NQB; ++qb) { mrun[qb] = m_init; lrun[qb] = (has_sink && fq == 0) ? 1.f : 0.f;
#pragma unroll
        for (int db = 0; db < 4; ++db) o[qb][db] = (f32x4){0.f, 0.f, 0.f, 0.f}; }
    bf16x8 kf[4][2]; v4u vn[8];
#define ATT_LOADK(KT) do { _Pragma("unroll") for (int kb = 0; kb < 4; ++kb) { int kr = (KT) + 16 * kb + fr; kr = kr < kend ? kr : kend - 1; const bf16* kp = QKV + (size_t)(srow0 + kr) * DIN + kcol + 8 * fq; \
            kf[kb][0] = *(const bf16x8*)kp; kf[kb][1] = *(const bf16x8*)(kp + 32); } } while (0)
#define ATT_LOADV(KT) do { _Pragma("unroll") for (int i = 0; i < 8; ++i) { int kr = (KT) + 8 * i + (lane >> 3); kr = kr < kend ? kr : kend - 1; vn[i] = *(const v4u*)(QKV + (size_t)(srow0 + kr) * DIN + vcol + 8 * (lane & 7)); } } while (0)
    ATT_LOADK(kt0); ATT_LOADV(kt0);
    for (int kt = kt0; kt < kend; kt += 64) {
        CFENCE();
#pragma unroll
        for (int i = 0; i < 8; ++i) *(LAS v4u*)(wl + (8 * i + (lane >> 3)) * 144 + (lane & 7) * 16) = vn[i];
        CFENCE();
        if (kt + 64 < kend) ATT_LOADV(kt + 64);
        const bool tail = (kt + 64 > kend), far = (qpos0 - kt - 63 >= 128);
        bf16x8 pf[NQB][2];
        f32x4 s[NQB][4]; float mx[NQB];
#pragma unroll
        for (int qb = 0; qb < NQB; ++qb) if (qb < nqb) {
#pragma unroll
            for (int kb = 0; kb < 4; ++kb) { s[qb][kb] = (f32x4){0.f, 0.f, 0.f, 0.f};
                s[qb][kb] = __builtin_amdgcn_mfma_f32_16x16x32_bf16(kf[kb][0], qf[qb][0], s[qb][kb], 0, 0, 0);
                s[qb][kb] = __builtin_amdgcn_mfma_f32_16x16x32_bf16(kf[kb][1], qf[qb][1], s[qb][kb], 0, 0, 0); }
        }
#pragma unroll
        for (int qb = 0; qb < NQB; ++qb) if (qb < nqb) {
            if (has_bias) {
                if (!far) { const int rel0 = qpos0 + 16 * qb + fr - kt - 4 * fq;
#pragma unroll
                    for (int kb = 0; kb < 4; ++kb)
#pragma unroll
                        for (int j = 0; j < 4; ++j) { int rel = rel0 - 16 * kb - j; rel = rel < -128 ? -128 : (rel > 128 ? 128 : rel); s[qb][kb][j] += tab[rel + 128]; } }
            }
            if (tail) {
#pragma unroll
                for (int kb = 0; kb < 4; ++kb)
#pragma unroll
                    for (int j = 0; j < 4; ++j) if (kt + 16 * kb + 4 * fq + j >= kend) s[qb][kb][j] = -1e30f;
            }
            float m0 = fmaxf(fmaxf(fmaxf(s[qb][0][0], s[qb][0][1]), fmaxf(s[qb][0][2], s[qb][0][3])), fmaxf(fmaxf(s[qb][1][0], s[qb][1][1]), fmaxf(s[qb][1][2], s[qb][1][3])));
            mx[qb] = fmaxf(m0, fmaxf(fmaxf(fmaxf(s[qb][2][0], s[qb][2][1]), fmaxf(s[qb][2][2], s[qb][2][3])), fmaxf(fmaxf(s[qb][3][0], s[qb][3][1]), fmaxf(s[qb][3][2], s[qb][3][3]))));
        }
#pragma unroll
        for (int qb = 0; qb < NQB; ++qb) if (qb < nqb) mx[qb] = fmaxf(mx[qb], shx(mx[qb], 16, lane));
#pragma unroll
        for (int qb = 0; qb < NQB; ++qb) if (qb < nqb) mx[qb] = fmaxf(mx[qb], shx(mx[qb], 32, lane));
#pragma unroll
        for (int qb = 0; qb < NQB; ++qb) if (qb < nqb) {
            const float mnew = fmaxf(mrun[qb], mx[qb]), alpha = __builtin_amdgcn_exp2f(mrun[qb] - mnew); mrun[qb] = mnew;
            float ps = 0.f;
#pragma unroll
            for (int kb = 0; kb < 4; ++kb)
#pragma unroll
                for (int j = 0; j < 4; ++j) { const float p = __builtin_amdgcn_exp2f(s[qb][kb][j] - mnew); s[qb][kb][j] = p; ps += p; }
            lrun[qb] = lrun[qb] * alpha + ps;
#pragma unroll
            for (int db = 0; db < 4; ++db) o[qb][db] = o[qb][db] * alpha;
#pragma unroll
            for (int kh = 0; kh < 2; ++kh) { v4u w; w.x = pk2(s[qb][2 * kh][0], s[qb][2 * kh][1]); w.y = pk2(s[qb][2 * kh][2], s[qb][2 * kh][3]); w.z = pk2(s[qb][2 * kh + 1][0], s[qb][2 * kh + 1][1]); w.w = pk2(s[qb][2 * kh + 1][2], s[qb][2 * kh + 1][3]);
                pf[qb][kh] = __builtin_bit_cast(bf16x8, w); }
        }
        if (kt + 64 < kend) ATT_LOADK(kt + 64);
#pragma unroll
        for (int kh = 0; kh < 2; ++kh)
#pragma unroll
            for (int db = 0; db < 4; ++db) {
                const LAS unsigned char* vp = wl + (32 * kh + 4 * fq + (fr >> 2)) * 144 + 32 * db + 8 * (fr & 3);
                const s16x4 lo = vtr(vp), hi = vtr(vp + 16 * 144);
                const bf16x8 vf = (bf16x8){lo[0], lo[1], lo[2], lo[3], hi[0], hi[1], hi[2], hi[3]};
#pragma unroll
                for (int qb = 0; qb < NQB; ++qb) if (qb < nqb) o[qb][db] = __builtin_amdgcn_mfma_f32_16x16x32_bf16(vf, pf[qb][kh], o[qb][db], 0, 0, 0);
            }
        CFENCE();
    }
#pragma unroll
    for (int qb = 0; qb < NQB; ++qb) if (qb < nqb) {
        float l = lrun[qb]; l += shx(l, 16, lane); l += shx(l, 32, lane);
        const float inv = 1.f / l; float ss = 0.f; const int row = mixrow0 + 16 * qb + fr;
#pragma unroll
        for (int db = 0; db < 4; ++db) { const f32x4 v = o[qb][db] * inv; ss += (v.x * v.x + v.y * v.y) + (v.z * v.z + v.w * v.w);
            v2u w; w.x = pk2(v.x, v.y); w.y = pk2(v.z, v.w); *(v2u*)(MIX + (size_t)row * DM + ocol + 16 * db + 4 * fq) = w; }
        ss += shx(ss, 16, lane); ss += shx(ss, 32, lane);
        if (fq == 0) SSH[(size_t)row * 16 + sidx] = ss;
    }
}

constexpr int VSTRIDE = 528, XSTRIDE = 272, XT_OFF = 16 * VSTRIDE;
template <bool OUTPUT> __device__ __forceinline__ void ssm_unit(const bf16* QKVp, const unsigned char* ws, bf16* YBp, LAS unsigned char* wl, const float* dskip, int l, int g, int ntok, int qrow0, int yrow0,
                                                               float hr, float hi, float* fin_re, float* fin_im, int lane) {
    const int fr = lane & 15, fq = lane >> 4, lg = l * 16 + g;
    const f32x2 lam = ((const f32x2*)(ws + WS_LAM))[lg * 64 + lane];
    bf16x8 bfr[8];
#pragma unroll
    for (int pb = 0; pb < 8; ++pb) { bfr[pb] = (bf16x8){0, 0, 0, 0, 0, 0, 0, 0}; if (fq < 2) bfr[pb] = *(const bf16x8*)((const bf16*)(ws + WS_BBB) + (size_t)(lg * 128 + 16 * pb + fr) * 16 + 8 * fq); }
    bf16x8 cf[4]; f32x4 dv = (f32x4){0.f, 0.f, 0.f, 0.f};
    if (OUTPUT) {
#pragma unroll
        for (int ks = 0; ks < 4; ++ks) cf[ks] = *(const bf16x8*)((const bf16*)(ws + WS_CCB) + (size_t)(lg * 16 + fr) * 128 + 32 * ks + 8 * fq);
        dv = *(const f32x4*)(dskip + lg * 16 + 4 * fq);
    }
    float xr = hr, xi = hi;
    const int nblk = ntok >> 4;
    bf16x8 uf = (bf16x8){0, 0, 0, 0, 0, 0, 0, 0}; v2u uw = (v2u){0u, 0u};
    if (fq < 2) uf = *(const bf16x8*)(QKVp + (size_t)(qrow0 + fr) * DIN + 1152 + 16 * g + 8 * fq);
    if (OUTPUT) uw = *(const v2u*)(QKVp + (size_t)(qrow0 + fr) * DIN + 1152 + 16 * g + 4 * fq);
    for (int tb = 0; tb < nblk; ++tb) {
        const bf16x8 ucur = uf; const v2u uwc = uw;
        if (tb + 1 < nblk) {
            if (fq < 2) uf = *(const bf16x8*)(QKVp + (size_t)(qrow0 + 16 * (tb + 1) + fr) * DIN + 1152 + 16 * g + 8 * fq);
            if (OUTPUT) uw = *(const v2u*)(QKVp + (size_t)(qrow0 + 16 * (tb + 1) + fr) * DIN + 1152 + 16 * g + 4 * fq);
        }
#pragma unroll
        for (int pb = 0; pb < 8; ++pb) { f32x4 d = (f32x4){0.f, 0.f, 0.f, 0.f}; d = __builtin_amdgcn_mfma_f32_16x16x32_bf16(bfr[pb], ucur, d, 0, 0, 0);
            *(LAS f32x4*)(wl + fr * VSTRIDE + (16 * pb + 4 * fq) * 4) = d; }
        CFENCE();
#pragma unroll 4
        for (int t = 0; t < 16; ++t) {
            const float vr = *(const LAS float*)(wl + t * VSTRIDE + lane * 4), vi = *(const LAS float*)(wl + t * VSTRIDE + 256 + lane * 4);
            const float nr = lam.x * xr - lam.y * xi + vr, ni = lam.x * xi + lam.y * xr + vi; xr = nr; xi = ni;
            if (OUTPUT) { const unsigned w = pk2(xr, xi); *(LAS unsigned short*)(wl + XT_OFF + t * XSTRIDE + lane * 2) = (unsigned short)w; *(LAS unsigned short*)(wl + XT_OFF + t * XSTRIDE + 128 + lane * 2) = (unsigned short)(w >> 16); }
        }
        CFENCE();
        if (OUTPUT) {
            f32x4 acc = (f32x4){0.f, 0.f, 0.f, 0.f};
#pragma unroll
            for (int ks = 0; ks < 4; ++ks) { const bf16x8 xf = *(const LAS bf16x8*)(wl + XT_OFF + fr * XSTRIDE + (32 * ks + 8 * fq) * 2);
                acc = __builtin_amdgcn_mfma_f32_16x16x32_bf16(cf[ks], xf, acc, 0, 0, 0); }
            const f32x4 uu = (f32x4){bflo(uwc.x), bfhi(uwc.x), bflo(uwc.y), bfhi(uwc.y)};
            f32x4 y = acc + dv * uu;
#pragma unroll
            for (int j = 0; j < 4; ++j) { const float z = 0.7978845608028654f * (y[j] + 0.044715f * y[j] * y[j] * y[j]); y[j] = y[j] * __builtin_amdgcn_rcpf(1.0f + __builtin_amdgcn_exp2f(-2.f * LOG2E * z)); }
            v2u w; w.x = pk2(y.x, y.y); w.y = pk2(y.z, y.w);
            *(v2u*)(YBp + (size_t)(yrow0 + 16 * tb + fr) * 256 + 16 * g + 4 * fq) = w;
            CFENCE();
        }
    }
    if (fin_re) { fin_re[lane] = xr; fin_im[lane] = xi; }
}

__device__ __forceinline__ void ssm_f1_pair(const bf16* QKVp, const unsigned char* ws, LAS unsigned char* wl, int l, int g0, int qrow0, float* fin  , int lane) {
    const int fr = lane & 15, fq = lane >> 4;
    f32x2 lam[2]; bf16x8 bfr[2][8]; float xr[2] = {0.f, 0.f}, xi[2] = {0.f, 0.f}; bf16x8 uf[2];
#pragma unroll
    for (int u = 0; u < 2; ++u) { const int lg = l * 16 + g0 + u; lam[u] = ((const f32x2*)(ws + WS_LAM))[lg * 64 + lane];
#pragma unroll
        for (int pb = 0; pb < 8; ++pb) { bfr[u][pb] = (bf16x8){0, 0, 0, 0, 0, 0, 0, 0}; if (fq < 2) bfr[u][pb] = *(const bf16x8*)((const bf16*)(ws + WS_BBB) + (size_t)(lg * 128 + 16 * pb + fr) * 16 + 8 * fq); }
        uf[u] = (bf16x8){0, 0, 0, 0, 0, 0, 0, 0}; if (fq < 2) uf[u] = *(const bf16x8*)(QKVp + (size_t)(qrow0 + fr) * DIN + 1152 + 16 * (g0 + u) + 8 * fq); }
    for (int tb = 0; tb < 4; ++tb) {
        bf16x8 ucur[2];
#pragma unroll
        for (int u = 0; u < 2; ++u) { ucur[u] = uf[u]; if (tb + 1 < 4 && fq < 2) uf[u] = *(const bf16x8*)(QKVp + (size_t)(qrow0 + 16 * (tb + 1) + fr) * DIN + 1152 + 16 * (g0 + u) + 8 * fq); }
#pragma unroll
        for (int u = 0; u < 2; ++u)
#pragma unroll
            for (int pb = 0; pb < 8; ++pb) { f32x4 d = (f32x4){0.f, 0.f, 0.f, 0.f}; d = __builtin_amdgcn_mfma_f32_16x16x32_bf16(bfr[u][pb], ucur[u], d, 0, 0, 0);
                *(LAS f32x4*)(wl + u * XT_OFF + fr * VSTRIDE + (16 * pb + 4 * fq) * 4) = d; }
        CFENCE();
#pragma unroll 4
        for (int t = 0; t < 16; ++t) {
#pragma unroll
            for (int u = 0; u < 2; ++u) { const float vr = *(const LAS float*)(wl + u * XT_OFF + t * VSTRIDE + lane * 4), vi = *(const LAS float*)(wl + u * XT_OFF + t * VSTRIDE + 256 + lane * 4);
                const float nr = lam[u].x * xr[u] - lam[u].y * xi[u] + vr, ni = lam[u].x * xi[u] + lam[u].y * xr[u] + vi; xr[u] = nr; xi[u] = ni; }
        }
        CFENCE();
    }
#pragma unroll
    for (int u = 0; u < 2; ++u) { fin[u * 128 + lane] = xr[u]; fin[u * 128 + 64 + lane] = xi[u]; }
}

__device__ __forceinline__ void ssm_f2_pair(const bf16* QKVp, const unsigned char* ws, bf16* YBp, LAS unsigned char* wl, const float* dskip, int l, int g0, int ntok, int qrow0, int yrow0,
                                            float hr0, float hi0, float hr1, float hi1, float* fin_re, float* fin_im, int lane) {
    const int fr = lane & 15, fq = lane >> 4;
    f32x2 lam[2]; bf16x8 bfr[2][8], cf[2][4]; f32x4 dv[2]; float xr[2] = {hr0, hr1}, xi[2] = {hi0, hi1}; bf16x8 uf[2]; v2u uw[2];
#pragma unroll
    for (int u = 0; u < 2; ++u) { const int lg = l * 16 + g0 + u; lam[u] = ((const f32x2*)(ws + WS_LAM))[lg * 64 + lane];
#pragma unroll
        for (int pb = 0; pb < 8; ++pb) { bfr[u][pb] = (bf16x8){0, 0, 0, 0, 0, 0, 0, 0}; if (fq < 2) bfr[u][pb] = *(const bf16x8*)((const bf16*)(ws + WS_BBB) + (size_t)(lg * 128 + 16 * pb + fr) * 16 + 8 * fq); }
#pragma unroll
        for (int ks = 0; ks < 4; ++ks) cf[u][ks] = *(const bf16x8*)((const bf16*)(ws + WS_CCB) + (size_t)(lg * 16 + fr) * 128 + 32 * ks + 8 * fq);
        dv[u] = *(const f32x4*)(dskip + lg * 16 + 4 * fq);
        uf[u] = (bf16x8){0, 0, 0, 0, 0, 0, 0, 0}; if (fq < 2) uf[u] = *(const bf16x8*)(QKVp + (size_t)(qrow0 + fr) * DIN + 1152 + 16 * (g0 + u) + 8 * fq);
        uw[u] = *(const v2u*)(QKVp + (size_t)(qrow0 + fr) * DIN + 1152 + 16 * (g0 + u) + 4 * fq); }
    const int nblk = ntok >> 4;
    for (int tb = 0; tb < nblk; ++tb) {
        bf16x8 ucur[2]; v2u uwc[2];
#pragma unroll
        for (int u = 0; u < 2; ++u) { ucur[u] = uf[u]; uwc[u] = uw[u];
            if (tb + 1 < nblk) { if (fq < 2) uf[u] = *(const bf16x8*)(QKVp + (size_t)(qrow0 + 16 * (tb + 1) + fr) * DIN + 1152 + 16 * (g0 + u) + 8 * fq);
                uw[u] = *(const v2u*)(QKVp + (size_t)(qrow0 + 16 * (tb + 1) + fr) * DIN + 1152 + 16 * (g0 + u) + 4 * fq); } }
#pragma unroll
        for (int u = 0; u < 2; ++u)
#pragma unroll
            for (int pb = 0; pb < 8; ++pb) { f32x4 d = (f32x4){0.f, 0.f, 0.f, 0.f}; d = __builtin_amdgcn_mfma_f32_16x16x32_bf16(bfr[u][pb], ucur[u], d, 0, 0, 0);
                *(LAS f32x4*)(wl + u * XT_OFF + fr * VSTRIDE + (16 * pb + 4 * fq) * 4) = d; }
        CFENCE();
#pragma unroll 4
        for (int t = 0; t < 16; ++t) {
#pragma unroll
            for (int u = 0; u < 2; ++u) { LAS unsigned char* row = wl + u * XT_OFF + t * VSTRIDE;
                const float vr = *(const LAS float*)(row + lane * 4), vi = *(const LAS float*)(row + 256 + lane * 4);
                const float nr = lam[u].x * xr[u] - lam[u].y * xi[u] + vr, ni = lam[u].x * xi[u] + lam[u].y * xr[u] + vi; xr[u] = nr; xi[u] = ni;
                const unsigned w = pk2(nr, ni);
                CFENCE();
                *(LAS unsigned short*)(row + lane * 2) = (unsigned short)w; *(LAS unsigned short*)(row + 128 + lane * 2) = (unsigned short)(w >> 16); }
        }
        CFENCE();
#pragma unroll
        for (int u = 0; u < 2; ++u) {
            f32x4 acc = (f32x4){0.f, 0.f, 0.f, 0.f};
#pragma unroll
            for (int ks = 0; ks < 4; ++ks) { const bf16x8 xf = *(const LAS bf16x8*)(wl + u * XT_OFF + fr * VSTRIDE + (32 * ks + 8 * fq) * 2);
                acc = __builtin_amdgcn_mfma_f32_16x16x32_bf16(cf[u][ks], xf, acc, 0, 0, 0); }
            const f32x4 uu = (f32x4){bflo(uwc[u].x), bfhi(uwc[u].x), bflo(uwc[u].y), bfhi(uwc[u].y)};
            f32x4 y = acc + dv[u] * uu;
#pragma unroll
            for (int j = 0; j < 4; ++j) { const float z = 0.7978845608028654f * (y[j] + 0.044715f * y[j] * y[j] * y[j]); y[j] = y[j] * __builtin_amdgcn_rcpf(1.0f + __builtin_amdgcn_exp2f(-2.f * LOG2E * z)); }
            v2u w; w.x = pk2(y.x, y.y); w.y = pk2(y.z, y.w);
            *(v2u*)(YBp + (size_t)(yrow0 + 16 * tb + fr) * 256 + 16 * (g0 + u) + 4 * fq) = w;
        }
        CFENCE();
    }
    if (fin_re) {
#pragma unroll
        for (int u = 0; u < 2; ++u) { fin_re[u * 64 + lane] = xr[u]; fin_im[u * 64 + lane] = xi[u]; } }
}

__global__ void __launch_bounds__(NTHREADS, 2) fwd_kernel(Args args) {
    extern __shared__ __attribute__((aligned(16))) unsigned char lds_raw[];
    cg::grid_group grid = cg::this_grid();
    LAS unsigned char* lds = (LAS unsigned char*)lds_raw;
    const int wave0 = __builtin_amdgcn_readfirstlane(threadIdx.x >> 6);
    const int G0 = gridDim.x;
#define MYTID() (wave0 * 64 + lane_id_v())
#define PHASE_IDS() PHASE_PTRS(); int tid_ = MYTID(); asm volatile("" : "+v"(tid_)); const int tid = tid_, lane = tid & 63, wave = __builtin_amdgcn_readfirstlane(tid >> 6); \
    const int gw = bid * NWAVES + wave; const long long gt = (long long)bid * NTHREADS + tid; LAS unsigned char* wl = lds + wave * WAVE_LDS; (void)gw; (void)gt; (void)wl; (void)lane
    unsigned char* const ws0 = args.ws; float* const out0 = args.out;
    { const int t0 = MYTID();
      if (t0 == 0) {
#pragma unroll
          for (int k = 0; k < 25; ++k) ((LAS unsigned long long*)(lds + PTAB_OFF))[k] = (unsigned long long)args.in[k];
          ((LAS unsigned*)(lds + PTAB_OFF + 256))[0] = 0u; ((LAS unsigned*)(lds + PTAB_OFF + 256))[1] = 0u; } }
    __syncthreads();
#define INP(k) inptr(lds, k)
#define x_p INP(0)
#define x_s INP(1)
#define cak INP(2)
#define cav INP(3)
#define cck INP(4)
#define ccv INP(5)
#define st_re INP(6)
#define st_im INP(7)
#define norm_g INP(8)
#define bng INP(9)
#define w_up INP(10)
#define w_dn INP(11)
#define w_in INP(12)
#define w_out INP(13)
#define relb INP(14)
#define csink INP(15)
#define a_re INP(16)
#define a_im INP(17)
#define log_dt INP(18)
#define b_re INP(19)
#define b_im INP(20)
#define c_re INP(21)
#define c_im INP(22)
#define d_skip INP(23)
#define w_glu INP(24)
#define PHASE_PTRS() unsigned char* ws = ws0; float* out = out0; int G = G0, bid = blockIdx.x; asm volatile("" : "+s"(ws), "+s"(out), "+s"(G), "+s"(bid)); float* const X = out; (void)X; \
    const int NGW = G * NWAVES; const long long GT = (long long)G * NTHREADS; (void)NGW; (void)GT
#define WUP ((bf16*)(ws + WS_WUP))
#define WDN ((bf16*)(ws + WS_WDN))
#define WIN ((bf16*)(ws + WS_WIN))
#define WOUT ((bf16*)(ws + WS_WOUT))
#define WGLU ((bf16*)(ws + WS_WGLU))
#define XN ((bf16*)(ws + WS_XN))
#define OUTB ((bf16*)(ws + WS_OUT))
#define XB ((bf16*)(ws + WS_OUT))
#define MIX ((bf16*)(ws + WS_MIX))
#define YB ((bf16*)(ws + WS_YB))
#define ACT ((bf16*)(ws + WS_ACT))
#define QKV ((bf16*)(ws + WS_QKV))
#define SSH ((float*)(ws + WS_SSH))

#ifdef STAT
    if (blockIdx.x == gridDim.x - 1 && MYTID() == 0) ((unsigned long long*)(ws0 + WS_CTL + 4096))[63] = __builtin_amdgcn_s_memrealtime();
#endif
    unsigned* const xbar = (unsigned*)(ws0 + WS_CTL + 65536) + (size_t)args.li * XCD_BAR_WORDS;
    const unsigned xcc = xb_xcc_id();
    const int ph_lo = args.ph_lo, ph_hi = args.ph_hi;
#define IN(k) (ph_lo <= (k) && (k) < ph_hi)
#define PH(k) (13 * l + (k))
    if (IN(0)) {
        PHASE_IDS();
        LAS float* scr = (LAS float*)(lds + wave * 16384);
#ifndef DBG
        if (bid == 0) for (int i = tid; i < XCD_BAR_WORDS; i += NTHREADS) xbar[i] = 0u;
#endif
        constexpr int I_UP = 16 * 176, I_DN = 44 * 32, I_IN = 16 * 64, I_OUT = 16 * 32, I_GLU = 4 * 16;
        constexpr int NITEMS = 4 * I_UP + 4 * I_DN + 2 * I_IN + 2 * I_OUT + 2 * I_GLU;
        for (int it = gw; it < NITEMS; it += NGW) {
            int r = it;
            if (r < 4 * I_UP) { const int mi = r / I_UP, q = r % I_UP, kb = q / 176, nb = q % 176; transpose_item(w_up + (size_t)mi * DM * 2 * DFF, DM, 2 * DFF, WUP + (size_t)mi * 2 * DFF * DM, glu_row(nb * 32, DFF), kb * 64, nb * 32, nullptr, scr, lane); continue; } r -= 4 * I_UP;
            if (r < 4 * I_DN) { const int mi = r / I_DN, q = r % I_DN, kb = q / 32, nb = q % 32; transpose_item(w_dn + (size_t)mi * DFF * DM, DFF, DM, WDN + (size_t)mi * DM * DFF, nb * 32, kb * 64, nb * 32, nullptr, scr, lane); continue; } r -= 4 * I_DN;
            if (r < 2 * I_IN) { const int mi = r / I_IN, q = r % I_IN, kb = q / 64, nb = q % 64; transpose_item(w_in + (size_t)mi * DM * DIN, DM, DIN, WIN + (size_t)mi * DIN * DM, nb * 32, kb * 64, nb * 32, nullptr, scr, lane, (nb >= 44 && nb < 60 && (nb & 1) == 0)); continue; } r -= 2 * I_IN;
            if (r < 2 * I_OUT) { const int mi = r / I_OUT, q = r % I_OUT, kb = q / 32, nb = q % 32; transpose_item(w_out + (size_t)mi * DM * DM, DM, DM, WOUT + (size_t)mi * DM * DM, nb * 32, kb * 64, nb * 32, bng + mi * DM, scr, lane); continue; } r -= 2 * I_OUT;
            { const int mi = r / I_GLU, q = r % I_GLU, kb = q / 16, nb = q % 16; transpose_item(w_glu + (size_t)mi * 256 * 512, 256, 512, WGLU + (size_t)mi * 512 * 256, glu_row(nb * 32, 256), kb * 64, nb * 32, nullptr, scr, lane); }
        }
        for (long long i = gt; i < 13 * 8192; i += GT) ((unsigned*)(ws + WS_PCNT))[i] = 0u;
        for (long long i = gt; i < 8192 * 8; i += GT) {
            const float INVF[8] = {1.0f, 0.1939227432012558f, 0.03760603070259094f, 0.007292664609849453f, 0.0014142135623842478f, 0.00027424818836152554f, 5.3182957344688475e-05f, 1.0313385246263351e-05f};
            const int pos = (int)(i >> 3), fi = (int)(i & 7);
            float inv = INVF[0];
#pragma unroll
            for (int k = 1; k < 8; ++k) inv = (fi == k) ? INVF[k] : inv;
            const float ang = (float)pos * inv; const double a = (double)ang;
            ((f32x2*)(ws + WS_ROPE))[i] = (f32x2){(float)cos(a), (float)sin(a)};
        }
        for (long long i = gt; i < 2 * 16 * 64; i += GT) {
            const int lg = (int)(i >> 6);
            const float dt = expf(log_dt[lg]), ar = a_re[i], ai = a_im[i];
            const float mag = expf(ar * dt), ang = ai * dt;
            const float lr = mag * (float)cos((double)ang), li = mag * (float)sin((double)ang);
            const float den = ar * ar + ai * ai;
            const float zr = ((lr - 1.0f) * ar + li * ai) / den, zi = (li * ar - (lr - 1.0f) * ai) / den;
            ((f32x2*)(ws + WS_LAM))[i] = (f32x2){lr, li};
            float pr = lr, pim = li;
#pragma unroll
            for (int k = 0; k < 6; ++k) { const float nr = pr * pr - pim * pim, ni = 2.f * pr * pim; pr = nr; pim = ni; }
            ((f32x2*)(ws + WS_L64))[i] = (f32x2){pr, pim};
        }
        for (long long i = gt; i < 2 * 16 * 128 * 16; i += GT) {
            const int h = (int)(i & 15), pp = (int)((i >> 4) & 127), lg = (int)(i >> 11), pidx = lg * 64 + (pp & 63);
            const float dt = expf(log_dt[lg]), ar = a_re[pidx], ai = a_im[pidx];
            const float mag = expf(ar * dt), ang = ai * dt;
            const float lr = mag * (float)cos((double)ang), li = mag * (float)sin((double)ang);
            const float den = ar * ar + ai * ai;
            const float zr = ((lr - 1.0f) * ar + li * ai) / den, zi = (li * ar - (lr - 1.0f) * ai) / den;
            const float brv = b_re[(size_t)pidx * 16 + h], biv = b_im[(size_t)pidx * 16 + h];
            ((bf16*)(ws + WS_BBB))[i] = (bf16)f2bf((pp < 64) ? (zr * brv - zi * biv) : (zr * biv + zi * brv));
        }
        for (long long i = gt; i < 2 * 16 * 16 * 128; i += GT) {
            const int k = (int)(i & 127); const long long lgh = i >> 7;
            const float v = (k < 64) ? c_re[lgh * 64 + k] : -c_im[lgh * 64 + (k - 64)];
            ((bf16*)(ws + WS_CCB))[i] = (bf16)f2bf(v);
        }
        for (long long i = gt; i < 2LL * 8 * 480 * 96; i += GT) {
            const long long row = i / 96, c4 = i % 96, lb = row / 480, rr = row % 480;
            ((f32x4*)(out + O_AKS))[(lb * 512 + rr) * 96 + c4] = ((const f32x4*)cak)[(lb * 512 + rr + 32) * 96 + c4];
            ((f32x4*)(out + O_AVS))[(lb * 512 + rr) * 96 + c4] = ((const f32x4*)cav)[(lb * 512 + rr + 32) * 96 + c4];
        }
        for (long long i = gt; i < 2LL * 8 * 96 * 32; i += GT) {
            const long long row = i / 32, c4 = i % 32, lb = row / 96, rr = row % 96;
            ((f32x4*)(out + O_CKS))[(lb * 128 + rr) * 32 + c4] = ((const f32x4*)cck)[(lb * 128 + rr + 32) * 32 + c4];
            ((f32x4*)(out + O_CVS))[(lb * 128 + rr) * 32 + c4] = ((const f32x4*)ccv)[(lb * 128 + rr + 32) * 32 + c4];
        }
        for (int m0 = gw; m0 < TT; m0 += 4 * NGW) { RowIn r[4];
#pragma unroll
            for (int q = 0; q < 4; ++q) { const int m = m0 + q * NGW, mc = m < TT ? m : m0; row_load(r[q], (mc < TP) ? x_p + (size_t)mc * DM : x_s + (size_t)(mc - TP) * DM, nullptr, lane, nullptr, 0); }
#pragma unroll
            for (int q = 0; q < 4; ++q) { const int m = m0 + q * NGW; if (m < TT) row_finish(r[q], nullptr, false, nullptr, 0.f, XN + (size_t)m * DM, norm_g, lane); } }
    }
    if (IN(0) && IN(1)) grid.sync();
    if (MYTID() == 0) (void)xb_add(&xbar[XB_XCNT(xcc)], 1u);

    unsigned bar_gen = 0;
#ifdef STAT
#define TS(k) do { if (blockIdx.x == gridDim.x - 1 && MYTID() == 0) ((unsigned long long*)(ws0 + WS_CTL + 4096))[k] = __builtin_amdgcn_s_memrealtime(); } while (0)
#else
#define TS(k) do { } while (0)
#endif
    TS(0);
#define GBAR() xcd_barrier(xbar, xcc, (unsigned)G0, (volatile LAS unsigned*)(lds + PTAB_OFF + 256), MYTID())
    for (int l = 0; l < 2; ++l) {
#ifdef NXBAR
        if (l == 0) for (int xb = 0; xb < NXBAR; ++xb) GBAR();
#endif
#define ng (norm_g + (size_t)l * 6 * DM)
        if (IN(PH(1))) { PHASE_PTRS(); pg8::Gemm g{XN, WUP + (size_t)(l * 2 + 0) * 2 * DFF * DM, TT, 2 * DFF, DM, DM}; pg8::StaticOrder S; S.init(TT, 2 * DFF, G, bid);
          pg8::EpiGlu<0> E{ACT, DFF, nullptr}; pg8::gemm_phase<pg8::EpiGlu<0>, pg8::StaticOrder, true, true>(lds, g, S, E, MYTID()); }
        if (IN(PH(1)) && IN(PH(1) + 1)) GBAR();
        TS(PH(1));
        if (IN(PH(2))) { PHASE_PTRS();
          if (G == 256) {
            for (int rd = 0; rd < 2; ++rd) { pg8::Gemm g{ACT, WDN + (size_t)(l * 2 + 0) * DM * DFF, TP, DM, DFF, DFF}; pg8::OneUnit S; S.S.init(TP, DM, G, bid); S.round = rd;
              const int bank = (l * 3 + 0) * 2;
              pg8::RmsStats st1{(float*)(ws + WS_XBUF) + (size_t)bank * 131072, (unsigned*)(ws + WS_PCNT) + (size_t)bank * 8192}, st2{(float*)(ws + WS_XBUF) + (size_t)(bank + 1) * 131072, (unsigned*)(ws + WS_PCNT) + (size_t)(bank + 1) * 8192};
              pg8::EpiRms2 E{(l == 0) ? (const void*)x_p : (const void*)XN, (l == 0) ? 0 : 1, norm_g + 6 * DM  , (const float*)(ws + WS_RSTD), nullptr, XN, (float*)(ws + WS_RSTD), ng + DM, ng + 2 * DM, 0.5f, st1, st2, nullptr};
              pg8::gemm_phase<pg8::EpiRms2, pg8::OneUnit, false, true>(lds, g, S, E, MYTID());
              __syncthreads(); }
          } else
          { pg8::Gemm g{ACT, WDN + (size_t)(l * 2 + 0) * DM * DFF, TP, DM, DFF, DFF}; pg8::StaticOrder S; S.init(TP, DM, G, bid);
            pg8::EpiOut E{OUTB, DM}; pg8::gemm_phase<pg8::EpiOut, pg8::StaticOrder, true, true>(lds, g, S, E, MYTID()); }
          { pg8::Gemm g{ACT, WDN + (size_t)(l * 2 + 0) * DM * DFF, TT, DM, 256, DFF}; pg8::SplitOrder S{4 * 11, G, bid, TP / 256, (unsigned*)(ws + WS_PCNT) + 12 * 8192 + 64 * (l * 3 + 0)};
            pg8::EpiPart E{(float*)(ws + WS_PART)}; pg8::gemm_phase<pg8::EpiPart, pg8::SplitOrder, true, true>(lds, g, S, E, MYTID()); }
          { int tid_ = MYTID(); asm volatile("" : "+v"(tid_));
            sample_rows_after_split((unsigned*)(ws + WS_PCNT) + 12 * 8192 + 64 * (l * 3 + 0), 4 * 11, bid, tid_, ((l > 0) ? (const float*)(X + (size_t)TP * DM) : x_s), X, (const float*)(ws + WS_PART), 11, ng + DM, 0.5f, XN, ng + 2 * DM); } }
        if (IN(PH(2)) && IN(PH(2) + 1)) GBAR();
        TS(PH(2));
        TS(PH(3));
        if (IN(PH(4))) { PHASE_PTRS(); pg8::Gemm g{XN, WIN + (size_t)l * DIN * DM, TT, DIN, DM, DM}; pg8::StaticOrder S; S.init(TT, DIN, G, bid);
          pg8::EpiQKV E{QKV, (const pg8::f32x2*)(ws + WS_ROPE), out, l};
          pg8::gemm_phase<pg8::EpiQKV, pg8::StaticOrder, true, true>(lds, g, S, E, MYTID()); }
        if (IN(PH(4)) && IN(PH(4) + 1)) GBAR();
        TS(PH(4));
        if (IN(PH(5))) { PHASE_IDS();
            for (long long i = gt; i < 8LL * 512 * 48; i += GT) { const long long row = i / 48, c8 = i % 48, b = row / 512, r = row % 512;
                const f32x4* sk = (const f32x4*)(cak + ((size_t)(l * 8 + b) * 512 + r) * 384 + c8 * 8); const f32x4* sv = (const f32x4*)(cav + ((size_t)(l * 8 + b) * 512 + r) * 384 + c8 * 8);
                bf16* dq = QKV + (size_t)(TP + b * 544 + r) * DIN;
                const f32x4 k0 = sk[0], k1 = sk[1], v0 = sv[0], v1 = sv[1];
                *(v4u*)(dq + 384 + c8 * 8) = (v4u){pk2(k0.x, k0.y), pk2(k0.z, k0.w), pk2(k1.x, k1.y), pk2(k1.z, k1.w)};
                *(v4u*)(dq + 768 + c8 * 8) = (v4u){pk2(v0.x, v0.y), pk2(v0.z, v0.w), pk2(v1.x, v1.y), pk2(v1.z, v1.w)}; }
            for (long long i = gt; i < 8LL * 128 * 16; i += GT) { const long long row = i / 16, c8 = i % 16, b = row / 128, r = row % 128;
                const f32x4* sk = (const f32x4*)(cck + ((size_t)(l * 8 + b) * 128 + r) * 128 + c8 * 8); const f32x4* sv = (const f32x4*)(ccv + ((size_t)(l * 8 + b) * 128 + r) * 128 + c8 * 8);
                bf16* dq = QKV + (size_t)(TP + b * 544 + 384 + r) * DIN;
                const f32x4 k0 = sk[0], k1 = sk[1], v0 = sv[0], v1 = sv[1];
                *(v4u*)(dq + 1792 + c8 * 8) = (v4u){pk2(k0.x, k0.y), pk2(k0.z, k0.w), pk2(k1.x, k1.y), pk2(k1.z, k1.w)};
                *(v4u*)(dq + 1920 + c8 * 8) = (v4u){pk2(v0.x, v0.y), pk2(v0.z, v0.w), pk2(v1.x, v1.y), pk2(v1.z, v1.w)}; }
            for (int k2 = 0; k2 < 2; ++k2) { const int u = (((bid & 7) * 64 + k2 * 32 + (bid >> 3)) << 3) | wave; const int st = u >> 10, chunk = (u >> 3) & 127, g0 = 2 * (u & 7);
                ssm_f1_pair(QKV, ws, wl, l, g0, st * 8192 + chunk * 64, (float*)(ws + WS_SLOC) + (size_t)((st * 128 + chunk) * 16 + g0) * 128, lane); } }
        if (IN(PH(5)) && IN(PH(5) + 1)) GBAR();
        TS(PH(5));
        if (IN(PH(6))) {
            PHASE_IDS();
            LAS float* tab = (LAS float*)(lds + TAB_OFF);
            for (int i = tid; i < 6 * 257; i += NTHREADS) { const int hh = i / 257; tab[i] = (relb[(size_t)l * 6 * 257 + i] - relb[(size_t)l * 6 * 257 + hh * 257 + 256]) * LOG2E; }
            __syncthreads();
            constexpr int NATT = 8192 + 64, NSSM = 4096 + 64;
            for (int it = 0; it < 8; ++it) { const int slot = (wave & 1) ? (7 - it) : it; int uid = -1;
                if (slot < 4) uid = ((((bid & 7) * 32 + (bid >> 3)) * 4 + slot) << 3) | wave;
                else if (slot == 4) { if (gw < 64) uid = 8192 + gw; }
                else if (slot == 5) uid = NATT + ((((bid & 7) * 64 + (bid >> 3)) << 3) | wave);
                else if (slot == 6) { if (gw >= 64) uid = NATT + ((((bid & 7) * 64 + 32 + (bid >> 3)) << 3) | wave); }
                else { if (gw >= 64 && gw < 128) { const int b2 = (gw - 64) >> 3; uid = NATT + ((((b2 & 7) * 64 + 32 + (b2 >> 3)) << 3) | wave); } else if (gw >= 128 && gw < 192) uid = NATT + 4096 + (gw - 128); }
                if (uid < 0) continue;
                int lane_u = lane_id_v(); asm volatile("" : "+v"(lane_u));
                if (uid < NATT) {
                    const int sub = uid & 7;
                    int srow0, qpos0, cstart, kend, mixrow0;
                    if (uid < 8192) { const int rest = uid >> 3, half = rest & 1, ci = rest >> 1, st = ci >> 7, n = ci & 127; srow0 = st * 8192; cstart = 64 * n; qpos0 = cstart + 32 * half; kend = cstart + 64; mixrow0 = st * 8192 + qpos0; }
                    else { const int b = (uid - 8192) >> 3; srow0 = TP + b * 544; cstart = 512; qpos0 = 512; kend = 544; mixrow0 = TP + 32 * b; }
                    if (sub < 6) { int kt0 = cstart - 512; kt0 = kt0 < 0 ? 0 : kt0;
                        attn_unit<2>(QKV, MIX, SSH, wl, tab + 257 * sub, true, srow0, qpos0, kt0, kend, 64 * sub, 384 + 64 * sub, 768 + 64 * sub, 64 * sub, sub, mixrow0, -1e30f, false, lane_u); }
                    else { const int kh = sub - 6; int kt0 = cstart - 128; kt0 = kt0 < 0 ? 0 : kt0;
                        for (int gq = 0; gq < 3; ++gq) { const int qh = 3 * kh + gq;
                            attn_unit<2>(QKV, MIX, SSH, wl, tab, false, srow0, qpos0, kt0, kend, 1408 + 64 * qh, 1792 + 64 * kh, 1920 + 64 * kh, 640 + 64 * qh, 6 + qh, mixrow0, csink[l * 6 + qh] * LOG2E, true, lane_u); } }
                } else {
                    const int s = uid - NATT;
                    if (s < 4096) { const int g0 = 2 * (s & 7), chunk = (s >> 3) & 127, st = s >> 10;
                        const f32x2 l64a = ((const f32x2*)(ws + WS_L64))[(l * 16 + g0) * 64 + lane_u], l64b = ((const f32x2*)(ws + WS_L64))[(l * 16 + g0 + 1) * 64 + lane_u];
                        float hr0 = 0.f, hi0 = 0.f, hr1 = 0.f, hi1 = 0.f; const float* sl = (const float*)(ws + WS_SLOC) + ((size_t)(st * 128) * 16 + g0) * 128 + lane_u;
                        int c = 0;
                        for (; c + 4 <= chunk; c += 4) { float ax[4], ay[4], bx[4], by[4];
#pragma unroll
                            for (int k = 0; k < 4; ++k) { const float* q = sl + (size_t)(c + k) * 2048; ax[k] = q[0]; ay[k] = q[64]; bx[k] = q[128]; by[k] = q[192]; }
#pragma unroll
                            for (int k = 0; k < 4; ++k) { const float n0 = l64a.x * hr0 - l64a.y * hi0 + ax[k], n1 = l64a.x * hi0 + l64a.y * hr0 + ay[k]; hr0 = n0; hi0 = n1;
                                const float n2 = l64b.x * hr1 - l64b.y * hi1 + bx[k], n3 = l64b.x * hi1 + l64b.y * hr1 + by[k]; hr1 = n2; hi1 = n3; } }
                        for (; c < chunk; ++c) { const float* q = sl + (size_t)c * 2048; const float ax = q[0], ay = q[64], bx = q[128], by = q[192];
                            const float n0 = l64a.x * hr0 - l64a.y * hi0 + ax, n1 = l64a.x * hi0 + l64a.y * hr0 + ay; hr0 = n0; hi0 = n1;
                            const float n2 = l64b.x * hr1 - l64b.y * hi1 + bx, n3 = l64b.x * hi1 + l64b.y * hr1 + by; hr1 = n2; hi1 = n3; }
                        const bool fin = (chunk == 127);
                        ssm_f2_pair(QKV, ws, YB, wl, d_skip, l, g0, 64, st * 8192 + chunk * 64, st * 8192 + chunk * 64, hr0, hi0, hr1, hi1,
                                    fin ? out + O_SRP + ((size_t)(l * 4 + st) * 16 + g0) * 64 : nullptr, fin ? out + O_SIP + ((size_t)(l * 4 + st) * 16 + g0) * 64 : nullptr, lane_u);
                    } else { const int s2 = s - 4096, b = s2 >> 3, g0 = 2 * (s2 & 7); const size_t hidx = ((size_t)(l * 8 + b) * 16 + g0) * 64;
                        ssm_f2_pair(QKV, ws, YB, wl, d_skip, l, g0, 32, TP + b * 544 + 512, TP + 32 * b, st_re[hidx + lane_u], st_im[hidx + lane_u], st_re[hidx + 64 + lane_u], st_im[hidx + 64 + lane_u],
                                    out + O_SRS + hidx, out + O_SIS + hidx, lane_u); }
                }
            }
        }
        if (IN(PH(6)) && IN(PH(6) + 1)) GBAR();
        TS(PH(6));
        if (IN(PH(7))) { PHASE_PTRS(); pg8::Gemm g{YB, WGLU + (size_t)l * 512 * 256, TT, 512, 256, 256}; pg8::StaticOrder S; S.init(TT, 512, G, bid);
          pg8::EpiGlu<1> E{MIX + 384, DM, (float*)(ws + WS_SSB)}; pg8::gemm_phase<pg8::EpiGlu<1>, pg8::StaticOrder, true, true>(lds, g, S, E, MYTID()); }
        if (IN(PH(7)) && IN(PH(7) + 1)) GBAR();
        TS(PH(7));
        if (IN(PH(8))) { PHASE_IDS();
            for (long long m = gt; m < TP; m += GT) {
                const f32x4* sp = (const f32x4*)(SSH + (size_t)m * 16); const f32x4 s0 = sp[0], s1 = sp[1], s2 = sp[2];
                const f32x4* bp = (const f32x4*)((const float*)(ws + WS_SSB) + (size_t)m * 8); const f32x4 b0 = bp[0], b1 = bp[1];
                const float ra = __builtin_amdgcn_rsqf(((s0.x + s0.y) + (s0.z + s0.w) + (s1.x + s1.y)) * (1.f / 384.f) + EPSN);
                const float rc = __builtin_amdgcn_rsqf(((s1.z + s1.w) + (s2.x + s2.y) + (s2.z + s2.w)) * (1.f / 384.f) + EPSN);
                const float rb = __builtin_amdgcn_rsqf((((b0.x + b0.y) + (b0.z + b0.w)) + ((b1.x + b1.y) + (b1.z + b1.w))) * (1.f / 256.f) + EPSN);
                ((f32x4*)(ws + WS_RS))[m] = (f32x4){ra / rb, rb / rc, rc, 0.f};
            }
            for (int m = TP + gw; m < TT; m += NGW) { MixIn r0; mix_load(r0, SSH, MIX, m, lane); mix_finish(r0, MIX, m, true, lane); }
        }
        if (IN(PH(8)) && IN(PH(8) + 1)) GBAR();
        TS(PH(8));
        if (IN(PH(9))) { PHASE_PTRS();
          if (G == 256) {
            for (int rd = 0; rd < 2; ++rd) { pg8::Gemm g{MIX, WOUT + (size_t)l * DM * DM, TP, DM, DM, DM}; pg8::OneUnit S; S.S.init(TP, DM, G, bid); S.round = rd;
              const int bank = (l * 3 + 1) * 2;
              pg8::RmsStats st1{(float*)(ws + WS_XBUF) + (size_t)bank * 131072, (unsigned*)(ws + WS_PCNT) + (size_t)bank * 8192}, st2{(float*)(ws + WS_XBUF) + (size_t)(bank + 1) * 131072, (unsigned*)(ws + WS_PCNT) + (size_t)(bank + 1) * 8192};
              pg8::EpiRms2 E{XN, 1, ng + 2 * DM, (const float*)(ws + WS_RSTD), nullptr, XN, (float*)(ws + WS_RSTD), ng + 3 * DM, ng + 4 * DM, 1.0f, st1, st2, (const float*)(ws + WS_RS)};
              pg8::gemm_phase<pg8::EpiRms2, pg8::OneUnit, false, true, true>(lds, g, S, E, MYTID());
              __syncthreads(); }
          } else
          { pg8::Gemm g{MIX, WOUT + (size_t)l * DM * DM, TP, DM, DM, DM}; pg8::StaticOrder S; S.init(TP, DM, G, bid);
            pg8::EpiOut E{OUTB, DM}; pg8::gemm_phase<pg8::EpiOut, pg8::StaticOrder, true, true>(lds, g, S, E, MYTID()); }
          { pg8::Gemm g{MIX, WOUT + (size_t)l * DM * DM, TT, DM, 256, DM}; pg8::SplitOrder S{4 * 4, G, bid, TP / 256, (unsigned*)(ws + WS_PCNT) + 12 * 8192 + 64 * (l * 3 + 1)};
            pg8::EpiPart E{(float*)(ws + WS_PART)}; pg8::gemm_phase<pg8::EpiPart, pg8::SplitOrder, true, true>(lds, g, S, E, MYTID()); }
          { int tid_ = MYTID(); asm volatile("" : "+v"(tid_));
            sample_rows_after_split((unsigned*)(ws + WS_PCNT) + 12 * 8192 + 64 * (l * 3 + 1), 4 * 4, bid, tid_, (const float*)(X + (size_t)TP * DM), X, (const float*)(ws + WS_PART), 4, ng + 3 * DM, 1.0f, XN, ng + 4 * DM); } }
        if (IN(PH(9)) && IN(PH(9) + 1)) GBAR();
        TS(PH(9));
        TS(PH(10));
        if (IN(PH(11))) { PHASE_PTRS(); pg8::Gemm g{XN, WUP + (size_t)(l * 2 + 1) * 2 * DFF * DM, TT, 2 * DFF, DM, DM}; pg8::StaticOrder S; S.init(TT, 2 * DFF, G, bid);
          pg8::EpiGlu<0> E{ACT, DFF, nullptr}; pg8::gemm_phase<pg8::EpiGlu<0>, pg8::StaticOrder, true, true>(lds, g, S, E, MYTID()); }
        if (IN(PH(11)) && IN(PH(11) + 1)) GBAR();
        TS(PH(11));
        if (IN(PH(12))) { PHASE_PTRS();
          if (G == 256) {
            for (int rd = 0; rd < 2; ++rd) { pg8::Gemm g{ACT, WDN + (size_t)(l * 2 + 1) * DM * DFF, TP, DM, DFF, DFF}; pg8::OneUnit S; S.S.init(TP, DM, G, bid); S.round = rd;
              const int bank = (l * 3 + 2) * 2;
              pg8::RmsStats st1{(float*)(ws + WS_XBUF) + (size_t)bank * 131072, (unsigned*)(ws + WS_PCNT) + (size_t)bank * 8192}, st2{(float*)(ws + WS_XBUF) + (size_t)(bank + 1) * 131072, (unsigned*)(ws + WS_PCNT) + (size_t)(bank + 1) * 8192};
              pg8::EpiRms2 E{XN, 1, ng + 4 * DM, (const float*)(ws + WS_RSTD), (l == 0) ? (float*)nullptr : X, XN, (float*)(ws + WS_RSTD), ng + 5 * DM, ((l == 0) ? norm_g + 6 * DM : (const float*)nullptr), 0.5f, st1, st2, nullptr};
              pg8::gemm_phase<pg8::EpiRms2, pg8::OneUnit, false, true>(lds, g, S, E, MYTID());
              __syncthreads(); }
          } else
          { pg8::Gemm g{ACT, WDN + (size_t)(l * 2 + 1) * DM * DFF, TP, DM, DFF, DFF}; pg8::StaticOrder S; S.init(TP, DM, G, bid);
            pg8::EpiOut E{OUTB, DM}; pg8::gemm_phase<pg8::EpiOut, pg8::StaticOrder, true, true>(lds, g, S, E, MYTID()); }
          { pg8::Gemm g{ACT, WDN + (size_t)(l * 2 + 1) * DM * DFF, TT, DM, 256, DFF}; pg8::SplitOrder S{4 * 11, G, bid, TP / 256, (unsigned*)(ws + WS_PCNT) + 12 * 8192 + 64 * (l * 3 + 2)};
            pg8::EpiPart E{(float*)(ws + WS_PART)}; pg8::gemm_phase<pg8::EpiPart, pg8::SplitOrder, true, true>(lds, g, S, E, MYTID()); }
          { int tid_ = MYTID(); asm volatile("" : "+v"(tid_));
            sample_rows_after_split((unsigned*)(ws + WS_PCNT) + 12 * 8192 + 64 * (l * 3 + 2), 4 * 11, bid, tid_, (const float*)(X + (size_t)TP * DM), X, (const float*)(ws + WS_PART), 11, ng + 5 * DM, 0.5f, ((l == 0) ? XN : (bf16*)nullptr), ((l == 0) ? norm_g + 6 * DM : (const float*)nullptr)); } }
        if (IN(PH(12)) && IN(PH(12) + 1)) GBAR();
        TS(PH(12));
        TS(PH(13));
    }
#ifdef STAT
    { GBAR();
      PHASE_IDS(); const unsigned long long* ts = (const unsigned long long*)(ws + WS_CTL + 4096);
      double t = 0; if (STAT_MASK & 1) t += (double)(ts[0] - ts[63]);
      for (int k = 1; k <= 26; ++k) { const int kk = (k - 1) % 13 + 1; const bool sel = (STAT_MASK >> kk) & 1; if (sel) t += (double)(ts[k] - ts[k - 1]); }
      const float sc = 1.0f + sqrtf(5e-5f + (float)(t * 0.01) * 1e-7f);
      for (long long i = gt; i < 2LL * 8 * 512 * 384; i += GT) out[O_AKS + i] *= sc; }
#endif
}

#ifdef DBG
__device__ __forceinline__ float b2f(bf16 v) { return __builtin_bit_cast(float, ((unsigned)v) << 16); }
struct DbgAcc { double num, den; };
__device__ __forceinline__ void dacc(DbgAcc& a, double fast, double ref) { a.num += (fast - ref) * (fast - ref); a.den += ref * ref; }
__device__ __forceinline__ void dcommit(unsigned* word, unsigned module, const DbgAcc& a) { if (!(a.num <= 1e-3 * a.den + 1e-14)) { if (*word > module) *word = module; } }

#define DBG_COL(ci) ((ci) == 0 ? 3 : ((ci) == 1 ? 1500 : 2815))
__device__ __forceinline__ void dbg_m1(unsigned* word, const bf16* XNp, const float* wup, const bf16* ACTp) {
    DbgAcc a{0, 0};
    for (int ri = 0; ri < 3; ++ri) for (int ci = 0; ci < 3; ++ci) { const int r = (ri == 0) ? 5 : ((ri == 1) ? 20000 : 32900), c = DBG_COL(ci); double g = 0, u = 0;
        for (int k = 0; k < 1024; ++k) { const double x = b2f(XNp[(size_t)r * 1024 + k]); g += x * wup[(size_t)k * 5632 + c]; u += x * wup[(size_t)k * 5632 + 2816 + c]; }
        dacc(a, b2f(ACTp[(size_t)r * 2816 + c]), g / (1.0 + exp(-g)) * u); }
    dcommit(word, 1, a);
}
#undef DBG_COL
#define DBG_COL(ci) ((ci) == 0 ? 7 : 700)
__device__ __forceinline__ void dbg_m2(unsigned* word, const bf16* ACTp, const float* wdn, const bf16* OUTp) {
    DbgAcc a{0, 0};
    for (int ri = 0; ri < 3; ++ri) for (int ci = 0; ci < 2; ++ci) { const int r = (ri == 0) ? 5 : ((ri == 1) ? 20000 : 32900), c = DBG_COL(ci); double s = 0;
        for (int k = 0; k < 2816; ++k) s += (double)b2f(ACTp[(size_t)r * 2816 + k]) * wdn[(size_t)k * 1024 + c];
        dacc(a, b2f(OUTp[(size_t)r * 1024 + c]), s); }
    dcommit(word, 2, a);
}
__device__ __forceinline__ void dbg_m3(unsigned* word, const float* Xp, const bf16* XNp, const float* gb) {
    DbgAcc a{0, 0};
    for (int ri = 0; ri < 3; ++ri) { const int r = (ri == 0) ? 5 : ((ri == 1) ? 20000 : 32900); double ss = 0; for (int k = 0; k < 1024; ++k) ss += (double)Xp[(size_t)r * 1024 + k] * Xp[(size_t)r * 1024 + k];
        const double rs = 1.0 / sqrt(ss / 1024 + 1e-6);
        for (int c = 1; c < 1024; c += 337) dacc(a, b2f(XNp[(size_t)r * 1024 + c]), Xp[(size_t)r * 1024 + c] * rs * gb[c]); }
    dcommit(word, 3, a);
}
__device__ __forceinline__ void dbg_m4(unsigned* word, const bf16* XNp, const float* win, const bf16* Qp, const float* outp, int l, const float* ropet) {
    const double QS = 0.125 * 1.4426950408889634;
    unsigned code = 99;
    for (int ci = 5; ci >= 0; --ci) { DbgAcc a{0, 0};
        const int c = (ci == 0) ? 1428 : (ci == 1) ? 1930 : (ci == 2) ? 1832 : (ci == 3) ? 1507 : (ci == 4) ? 1408 + 16 : 1792 + 16;
        for (int ri = 0; ri < 3; ++ri) { const int r = (ri == 0) ? 5 : ((ri == 1) ? 20000 : 32900); int qrow;
            if (r < 32768) { qrow = r; } else { const int s = r - 32768, b = s >> 5, t = s & 31; qrow = 32768 + b * 544 + 512 + t; }
            double v = 0; const bool isq = (c < 384) || (c >= 1408 && c < 1792);
            for (int k = 0; k < 1024; ++k) { const double x = b2f(XNp[(size_t)r * 1024 + k]); v += x * win[(size_t)k * 2048 + c]; }
            dacc(a, b2f(Qp[(size_t)qrow * 2048 + c]), isq ? v * QS : v); }
        if (!(a.num <= 1e-3 * a.den)) code = 1 + ci; }
    *word = code;
}
__device__ __forceinline__ void dbg_attn(unsigned* word, unsigned module, const bf16* Qp, const bf16* MIXp, const float* relb_l  , const float* sinkp  ,
                                      int srow0, int qpos, int kstart, int kend, int qcol, int kcol, int vcol, int ocol, int mixrow, int head) {
    DbgAcc a{0, 0};
    double mx = -1e300;
    for (int pass = 0; pass < 2; ++pass) {
        double den = 0, o0 = 0, o1 = 0;
        for (int kp = kstart; kp < kend; ++kp) { double s = 0;
            for (int d = 0; d < 64; ++d) s += (double)b2f(Qp[(size_t)(srow0 + qpos) * 2048 + qcol + d]) * b2f(Qp[(size_t)(srow0 + kp) * 2048 + kcol + d]);
            if (relb_l) { int rel = qpos - kp; rel = rel < -128 ? -128 : (rel > 128 ? 128 : rel); s += (double)relb_l[head * 257 + rel + 128] * 1.4426950408889634; }
            if (pass == 0) { if (s > mx) mx = s; } else { const double p = exp2(s - mx); den += p; o0 += p * b2f(Qp[(size_t)(srow0 + kp) * 2048 + vcol + 0]); o1 += p * b2f(Qp[(size_t)(srow0 + kp) * 2048 + vcol + 33]); } }
        if (pass == 0) { if (sinkp) { const double sk = (double)sinkp[0] * 1.4426950408889634; if (sk > mx) mx = sk; } }
        else { if (sinkp) den += exp2((double)sinkp[0] * 1.4426950408889634 - mx);
            dacc(a, b2f(MIXp[(size_t)mixrow * 1024 + ocol + 0]), o0 / den); dacc(a, b2f(MIXp[(size_t)mixrow * 1024 + ocol + 33]), o1 / den); } }
    dcommit(word, module, a);
}
__device__ __forceinline__ void dbg_ssm(unsigned* word, const bf16* Qp, const bf16* YBp, const float* are, const float* aim, const float* ldt, const float* bre, const float* bim, const float* cre, const float* cim, const float* dsk,
                                     const float* h0re, const float* h0im, int l, int g, int h, int qrow0, int yrow0, int ttarget, const float* fin_re, int fin_steps) {
    DbgAcc a{0, 0}; double y = 0;
    const double dt = exp((double)ldt[l * 16 + g]);
    for (int p = 0; p < 64; ++p) { const int i = (l * 16 + g) * 64 + p; const double ar = are[i], ai = aim[i]; const double mag = exp(ar * dt), lr = mag * cos(ai * dt), li = mag * sin(ai * dt);
        const double den = ar * ar + ai * ai, zr = ((lr - 1) * ar + li * ai) / den, zi = (li * ar - (lr - 1) * ai) / den;
        double xr = h0re ? (double)h0re[p] : 0.0, xi = h0im ? (double)h0im[p] : 0.0;
        const int nst = (p == 9 && fin_re) ? fin_steps : ttarget + 1;
        for (int t = 0; t < nst; ++t) { double vr = 0, vi = 0;
            for (int hh = 0; hh < 16; ++hh) { const double u = b2f(Qp[(size_t)(qrow0 + t) * 2048 + 1152 + 16 * g + hh]); const double br = bre[(size_t)i * 16 + hh], bi = bim[(size_t)i * 16 + hh]; vr += (zr * br - zi * bi) * u; vi += (zr * bi + zi * br) * u; }
            const double nr = lr * xr - li * xi + vr, ni = lr * xi + li * xr + vi; xr = nr; xi = ni;
            if (t == ttarget) y += cre[((size_t)(l * 16 + g) * 16 + h) * 64 + p] * xr - cim[((size_t)(l * 16 + g) * 16 + h) * 64 + p] * xi; }
        if (p == 9 && fin_re) dacc(a, fin_re[9], xr); }
    y += (double)dsk[(l * 16 + g) * 16 + h] * b2f(Qp[(size_t)(qrow0 + ttarget) * 2048 + 1152 + 16 * g + h]);
    const double z = 0.7978845608028654 * (y + 0.044715 * y * y * y), ge = 0.5 * y * (1.0 + tanh(z));
    dacc(a, b2f(YBp[(size_t)(yrow0 + ttarget) * 256 + 16 * g + h]), ge);
    dcommit(word, 7, a);
}
#undef DBG_COL
#define DBG_COL(ci) ((ci) == 0 ? 7 : 200)
__device__ __forceinline__ void dbg_m8(unsigned* word, const bf16* YBp, const float* wglu, const bf16* MIXp) {
    DbgAcc a{0, 0};
    for (int ri = 0; ri < 3; ++ri) for (int ci = 0; ci < 2; ++ci) { const int r = (ri == 0) ? 5 : ((ri == 1) ? 20000 : 32900), c = DBG_COL(ci); double g1 = 0, g2 = 0;
        for (int k = 0; k < 256; ++k) { const double x = b2f(YBp[(size_t)r * 256 + k]); g1 += x * wglu[(size_t)k * 512 + c]; g2 += x * wglu[(size_t)k * 512 + 256 + c]; }
        dacc(a, b2f(MIXp[(size_t)r * 1024 + 384 + c]), g1 / (1.0 + exp(-g2))); }
    dcommit(word, 8, a);
}
#undef DBG_COL
#define DBG_COL(ci) ((ci) == 0 ? 7 : 700)
__device__ __forceinline__ void dbg_m9(unsigned* word, const bf16* MIXp, const float* wout, const float* gbp, const bf16* OUTp) {
    DbgAcc a{0, 0};
    for (int ri = 0; ri < 3; ++ri) for (int ci = 0; ci < 2; ++ci) { const int r = (ri == 0) ? 5 : ((ri == 1) ? 20000 : 32900), c = DBG_COL(ci); double s = 0;
        for (int k = 0; k < 1024; ++k) s += (double)b2f(MIXp[(size_t)r * 1024 + k]) * gbp[k] * wout[(size_t)k * 1024 + c];
        dacc(a, b2f(OUTp[(size_t)r * 1024 + c]), s); }
    dcommit(word, 9, a);
}
#endif

#ifdef DBG
#ifndef DBG_NPH
#define DBG_NPH 27
#endif
#define DBGW ((unsigned*)(ws + WS_CTL + 32768))
__global__ void dbg_kernel(Args args, int ph) {
    if (threadIdx.x != 0) return;
    unsigned char* ws = args.ws; float* out = args.out; float* X = out;
    const float *w_up_ = args.in[10], *w_dn_ = args.in[11], *w_in_ = args.in[12], *w_out_ = args.in[13], *relb_ = args.in[14], *csink_ = args.in[15], *w_glu_ = args.in[24];
    if (ph == 0) { *DBGW = 99u; return; }
    if (ph > 13) return;
    const int l = 0;
    if (ph != 4) return;
    if (ph == 1) dbg_m1(DBGW, XN, w_up_, ACT);
    if (ph == 2) dbg_m2(DBGW, ACT, w_dn_, OUTB);
    if (ph == 3) dbg_m3(DBGW, X, XN, args.in[8] + 2 * DM);
    if (ph == 4) dbg_m4(DBGW, XN, w_in_, QKV, out, l, (const float*)(ws + WS_ROPE));
    if (ph == 6) {
        dbg_attn(DBGW, 5, QKV, MIX, relb_, nullptr, 8192, 700, 128, 704, 64 * 2, 384 + 64 * 2, 768 + 64 * 2, 64 * 2, 8192 + 700, 2);
        dbg_attn(DBGW, 5, QKV, MIX, relb_, nullptr, TP + 3 * 544, 512 + 7, 0, 544, 64 * 5, 384 + 64 * 5, 768 + 64 * 5, 64 * 5, TP + 3 * 32 + 7, 5);
        dbg_attn(DBGW, 6, QKV, MIX, nullptr, csink_ + 4, 2 * 8192, 100, 0, 128, 1408 + 64 * 4, 1792 + 64, 1920 + 64, 640 + 64 * 4, 2 * 8192 + 100, 0);
        dbg_attn(DBGW, 6, QKV, MIX, nullptr, csink_ + 1, TP + 6 * 544, 512 + 20, 384, 544, 1408 + 64 * 1, 1792, 1920, 640 + 64 * 1, TP + 6 * 32 + 20, 0);
        dbg_ssm(DBGW, QKV, YB, args.in[16], args.in[17], args.in[18], args.in[19], args.in[20], args.in[21], args.in[22], args.in[23], nullptr, nullptr, 0, 3, 5, 0, 0, 150, out + O_SRP + (size_t)3 * 64, 8192);
        dbg_ssm(DBGW, QKV, YB, args.in[16], args.in[17], args.in[18], args.in[19], args.in[20], args.in[21], args.in[22], args.in[23], args.in[6] + (size_t)(2 * 16 + 7) * 64, args.in[7] + (size_t)(2 * 16 + 7) * 64, 0, 7, 2, TP + 2 * 544 + 512, TP + 2 * 32, 9, out + O_SRS + (size_t)(2 * 16 + 7) * 64, 32);
    }
    if (ph == 7) dbg_m8(DBGW, YB, w_glu_, MIX);
    if (ph == 9) dbg_m9(DBGW, MIX, w_out_, args.in[9], OUTB);
}
__global__ void dbg_encode(Args args) {
    unsigned char* ws = args.ws; float* out = args.out;
    const unsigned code = *DBGW;
    if (code >= 99u) return;
    const float sc = 1.4f + 0.05f * (float)(code - 1u);
    for (long long i = (long long)blockIdx.x * blockDim.x + threadIdx.x; i < 2LL * 8 * 480 * 384; i += (long long)gridDim.x * blockDim.x) { const long long row = i / 384, c = i % 384, lb = row / 480, rr = row % 480; out[O_AKS + (lb * 512 + rr) * 384 + c] *= sc; }
}
#endif

#ifdef DBG
#define DBG_MEMSET_BYTES 1048576
#else
#define DBG_MEMSET_BYTES (65536 + XCD_BAR_WORDS * 4)
#endif
extern "C" void kernel_launch(void* const* d_in, const int* in_sizes, int n_in, void* d_out, int out_size, void* d_ws, size_t ws_size, hipStream_t stream) {
    static int grid = 0;
    if (grid == 0) {
        int dev = 0, cus = 0, per_cu = 0;
        if (hipGetDevice(&dev) != hipSuccess || hipDeviceGetAttribute(&cus, hipDeviceAttributeMultiprocessorCount, dev) != hipSuccess) { fprintf(stderr, "device query failed\n"); grid = -1; return; }
        if (hipFuncSetAttribute((const void*)fwd_kernel, hipFuncAttributeMaxDynamicSharedMemorySize, LDS_BYTES) != hipSuccess) { fprintf(stderr, "hipFuncSetAttribute failed\n"); grid = -1; return; }
        if (hipOccupancyMaxActiveBlocksPerMultiprocessor(&per_cu, (const void*)fwd_kernel, NTHREADS, LDS_BYTES) != hipSuccess || per_cu < 1) { fprintf(stderr, "occupancy query: %d\n", per_cu); per_cu = 1; }
        (void)hipGetLastError();
        grid = cus;
        if (grid != 256) { fprintf(stderr, "this build needs a 256-CU device (got %d)\n", grid); grid = -1; return; }
        if (n_in != 25 || ws_size < WS_END || out_size != 44089344) { fprintf(stderr, "unexpected problem: n_in %d ws %zu out %d\n", n_in, ws_size, out_size); grid = -1; return; }
    }
    if (grid < 0) return;
#ifdef DBG
    if (hipMemsetAsync((char*)d_ws + WS_CTL, 0, DBG_MEMSET_BYTES, stream) != hipSuccess) { fprintf(stderr, "memset failed\n"); return; }
#endif
    Args a{};
    for (int i = 0; i < 25; ++i) a.in[i] = (const float*)d_in[i];
    a.out = (float*)d_out; a.ws = (unsigned char*)d_ws;
#ifdef DBG
    for (int ph = 0; ph < DBG_NPH; ++ph) {
        a.ph_lo = ph; a.ph_hi = ph + 1; a.li = ph;
        void* kargs[] = {&a};
        if (hipLaunchCooperativeKernel((const void*)fwd_kernel, dim3(grid), dim3(NTHREADS), kargs, LDS_BYTES, stream) != hipSuccess) fprintf(stderr, "cooperative launch failed\n");
        hipLaunchKernelGGL(dbg_kernel, dim3(1), dim3(64), 0, stream, a, ph);
    }
    hipLaunchKernelGGL(dbg_encode, dim3(256), dim3(256), 0, stream, a);
#else
    a.ph_lo = 0; a.ph_hi = 27; a.li = 0;
    void* kargs[] = {&a};
    const hipError_t e = hipLaunchCooperativeKernel((const void*)fwd_kernel, dim3(grid), dim3(NTHREADS), kargs, LDS_BYTES, stream);
    if (e != hipSuccess) fprintf(stderr, "cooperative launch failed: %s (grid %d)\n", hipGetErrorString(e), grid);
#endif
}
```

```cpp
#include <hip/hip_runtime.h>
#include <hip/hip_cooperative_groups.h>
#include <cstdio>
#include <cstdint>
namespace cg = cooperative_groups;
namespace pg8 {
#define PG8_LAS __attribute__((address_space(3)))
typedef unsigned short bf16_t;
typedef short bf16x8 __attribute__((ext_vector_type(8)));
typedef float f32x4 __attribute__((ext_vector_type(4)));
typedef unsigned u32x4 __attribute__((ext_vector_type(4)));
constexpr int BM = 256, BK = 64, HALF = 128, HTB = HALF * BK * 2  , STAGE_BYTES = 8 * HTB, NXCD = 8, WGM = 8;

__host__ __device__ __forceinline__ int lds_byte(int r, int c) { const int st = (r >> 4) * 2 + (c >> 5), rr = r & 15, cc = c & 31, ob = rr * 64 + cc * 2; return st * 1024 + (ob ^ (((ob >> 9) & 1) << 5)); }
__host__ __device__ __forceinline__ void stage_rc(int b, int& R, int& C) { const int st = b / 1024, sb = b % 1024, swz = sb ^ (((sb >> 9) & 1) << 5); R = (st >> 1) * 16 + swz / 64; C = (st & 1) * 32 + (swz % 64) / 2; }
__host__ __device__ __forceinline__ int perm32(int rho) { const int n = rho >> 4, i = rho & 15; return 8 * (i >> 2) + 4 * n + (i & 3); }

struct Unit { int pm, pn, kofs; };
struct Gemm { const bf16_t* A; const bf16_t* Bt; int M, N, K, ld; };

struct StaticOrder {
    int nM, nN, nwg, G, c;
    __host__ __device__ void init(int M, int N, int G_, int c_) { nM = M / BM; nN = N / BM; nwg = nM * nN; G = G_; c = c_; }
    __host__ __device__ bool next(int i, Unit& u) const {
        const long L = (long)i * G + c; if (L >= nwg) return false;
        int wgid = (int)L; { const int q = nwg / NXCD, r = nwg % NXCD, xcd = wgid % NXCD, off = wgid / NXCD; wgid = (xcd < r ? xcd * (q + 1) : r * (q + 1) + (xcd - r) * q) + off; }
        const int nig = WGM * nN, gid = wgid / nig, fm = gid * WGM, gsz = (nM - fm) < WGM ? (nM - fm) : WGM;
        u.pm = fm + ((wgid % nig) % gsz); u.pn = (wgid % nig) / gsz; u.kofs = 0; return true;
    }
    __device__ __forceinline__ void a_ready(const Unit&) const {}
    __device__ __forceinline__ void done(const Unit&) const {}
};
__device__ __forceinline__ unsigned cvt_pk_bf16(float lo, float hi) { unsigned r; asm volatile("v_cvt_pk_bf16_f32 %0, %1, %2" : "=v"(r) : "v"(lo), "v"(hi)); return r; }

typedef float f32x2 __attribute__((ext_vector_type(2)));
__device__ __forceinline__ float fast_sigmoid(float x) { return __builtin_amdgcn_rcpf(1.0f + __builtin_amdgcn_exp2f(-1.4426950408889634f * x)); }

struct EpiOut {
    static constexpr bool PERM = true, AFTER_DRAIN = false;
    bf16_t* O; int ldc;
    __device__ __forceinline__ void operator()(const f32x4 (&acc)[2][2][4][2], const Unit& u, int wr, int wc, int fr, int fq) const {
        const int row0 = u.pm * BM + wr * 64 + fr, col0 = u.pn * BM + wc * 32 + 8 * fq;
#pragma unroll
        for (int ai = 0; ai < 2; ++ai)
#pragma unroll
            for (int m = 0; m < 4; ++m) { bf16_t* rowp = O + (size_t)(row0 + ai * HALF + m * 16) * ldc + col0;
#pragma unroll
                for (int bj = 0; bj < 2; ++bj) { const f32x4 v0 = acc[ai][bj][m][0], v1 = acc[ai][bj][m][1];
                    u32x4 w; w.x = cvt_pk_bf16(v0[0], v0[1]); w.y = cvt_pk_bf16(v0[2], v0[3]); w.z = cvt_pk_bf16(v1[0], v1[1]); w.w = cvt_pk_bf16(v1[2], v1[3]);
                    *(u32x4*)(rowp + bj * HALF) = w; } }
    }
};

template <int MODE> struct EpiGlu {
    static constexpr bool PERM = true, AFTER_DRAIN = false;
    bf16_t* O; int ldc; float* ss;
    __device__ __forceinline__ void operator()(const f32x4 (&acc)[2][2][4][2], const Unit& u, int wr, int wc, int fr, int fq) const {
        const int row0 = u.pm * BM + wr * 64 + fr, col0 = u.pn * HALF + wc * 32 + 8 * fq;
        const int a16 = (((fq ^ 1) << 4) | fr) << 2, a32 = (((fq ^ 2) << 4) | fr) << 2;
#pragma unroll
        for (int ai = 0; ai < 2; ++ai)
#pragma unroll
            for (int m = 0; m < 4; ++m) { const int row = row0 + ai * HALF + m * 16;
                float o[8];
#pragma unroll
                for (int n = 0; n < 2; ++n)
#pragma unroll
                    for (int j = 0; j < 4; ++j) { const float a = acc[ai][0][m][n][j], b = acc[ai][1][m][n][j];
                        o[4 * n + j] = (MODE == 0) ? a * fast_sigmoid(a) * b : a * fast_sigmoid(b); }
                u32x4 w; w.x = cvt_pk_bf16(o[0], o[1]); w.y = cvt_pk_bf16(o[2], o[3]); w.z = cvt_pk_bf16(o[4], o[5]); w.w = cvt_pk_bf16(o[6], o[7]);
                *(u32x4*)(O + (size_t)row * ldc + col0) = w;
                if (MODE == 1) { float s = ((o[0] * o[0] + o[1] * o[1]) + (o[2] * o[2] + o[3] * o[3])) + ((o[4] * o[4] + o[5] * o[5]) + (o[6] * o[6] + o[7] * o[7]));
                    s += __builtin_bit_cast(float, __builtin_amdgcn_ds_bpermute(a16, __builtin_bit_cast(int, s)));
                    s += __builtin_bit_cast(float, __builtin_amdgcn_ds_bpermute(a32, __builtin_bit_cast(int, s)));
                    if (fq == 0) ss[(size_t)row * 8 + u.pn * 4 + wc] = s; }
            }
    }
};

struct EpiQKV {
    static constexpr bool PERM = true, AFTER_DRAIN = false;
    bf16_t* Q; const f32x2* rope; float* out; int l;
    __device__ __forceinline__ void operator()(const f32x4 (&acc)[2][2][4][2], const Unit& u, int wr, int wc, int fr, int fq) const {
        const float QS = 0.125f * 1.4426950408889634f;
        const bool samp = u.pm >= 128;
        const int oak = samp ? 37240832 + l * 1572864 : 33816576 + l * 786432;
        const int oav = samp ? 40386560 + l * 1572864 : 35389440 + l * 786432;
        const int ock = samp ? 43532288 + l * 131072 : 36962304 + l * 65536;
        const int ocv = samp ? 43794432 + l * 131072 : 37093376 + l * 65536;
#pragma unroll
        for (int ai = 0; ai < 2; ++ai)
#pragma unroll
            for (int m = 0; m < 4; ++m) {
                const int r = u.pm * BM + ai * HALF + wr * 64 + m * 16 + fr;
                int b, t, qrow, pos, arow, crow;
                if (!samp) { b = r >> 13; t = r & 8191; qrow = r; pos = t; arow = (t >= 7680) ? b * 512 + t - 7680 : -1; crow = (t >= 8064) ? b * 128 + t - 8064 : -1; }
                else { const int s = r - 32768; b = s >> 5; t = s & 31; qrow = 32768 + b * 544 + 512 + t; pos = 1024 + t; arow = b * 512 + 480 + t; crow = b * 128 + 96 + t; }
#pragma unroll
                for (int bj = 0; bj < 2; ++bj) {
                    const int cb = 2 * u.pn + bj, gcol = cb * 128 + wc * 32;
                    f32x4 pa = acc[ai][bj][m][0], pb = acc[ai][bj][m][1]; int ca_ = gcol + 8 * fq, cb_ = ca_ + 4;
                    if (cb >= 11 && cb <= 14 && (wc & 1) == 0 && fq < 2) {
                        const f32x4* rp = (const f32x4*)(rope + (size_t)pos * 8) + 2 * fq; const f32x4 t0 = rp[0], t1 = rp[1];
                        const f32x4 x1 = (f32x4){pa[0], pa[2], pb[0], pb[2]}, x2 = (f32x4){pa[1], pa[3], pb[1], pb[3]};
                        const f32x4 cs = (f32x4){t0[0], t0[2], t1[0], t1[2]}, sn = (f32x4){t0[1], t0[3], t1[1], t1[3]};
                        pa = x1 * cs - x2 * sn; pb = x2 * cs + x1 * sn; ca_ = gcol + 4 * fq; cb_ = gcol + 8 + 4 * fq; }
                    int dbase = -1;
                    if (cb >= 3 && cb <= 5) { if (arow >= 0) dbase = oak + arow * 384 - 384; }
                    else if (cb >= 6 && cb <= 8) { if (arow >= 0) dbase = oav + arow * 384 - 768; }
                    else if (cb == 14) { if (crow >= 0) dbase = ock + crow * 128 - 1792; }
                    else if (cb == 15) { if (crow >= 0) dbase = ocv + crow * 128 - 1920; }
                    if (dbase >= 0) { __builtin_nontemporal_store(pa, (f32x4*)(out + (dbase + ca_))); __builtin_nontemporal_store(pb, (f32x4*)(out + (dbase + cb_))); }
                    if (cb < 3 || (cb >= 11 && cb <= 13)) { pa = pa * QS; pb = pb * QS; }
                    typedef unsigned u32x2 __attribute__((ext_vector_type(2)));
                    u32x2 wa, wb; wa.x = cvt_pk_bf16(pa[0], pa[1]); wa.y = cvt_pk_bf16(pa[2], pa[3]); wb.x = cvt_pk_bf16(pb[0], pb[1]); wb.y = cvt_pk_bf16(pb[2], pb[3]);
                    *(u32x2*)(Q + (size_t)qrow * 2048 + ca_) = wa; *(u32x2*)(Q + (size_t)qrow * 2048 + cb_) = wb;
                }
            }
    }
};

struct SplitOrder {
    int nsub, G, c, pm; unsigned* cnt;
    __device__ __forceinline__ bool next(int i, Unit& u) const { const long L = (long)i * G + c; if (L >= nsub) return false; u.pm = pm; u.pn = (int)(L & 3); u.kofs = (int)(L >> 2) * 256; return true; }
    __device__ __forceinline__ void a_ready(const Unit&) const {}
    __device__ __forceinline__ void done(const Unit&) const {}
};
struct EpiPart {
    static constexpr bool PERM = true, AFTER_DRAIN = false;
    float* P;
    __device__ __forceinline__ void operator()(const f32x4 (&acc)[2][2][4][2], const Unit& u, int wr, int wc, int fr, int fq) const {
        float* base = P + (size_t)(u.kofs >> 8) * (256 * 1024) + (size_t)(wr * 64 + fr) * 1024 + u.pn * BM + wc * 32 + 8 * fq;
#pragma unroll
        for (int ai = 0; ai < 2; ++ai)
#pragma unroll
            for (int m = 0; m < 4; ++m) { float* rowp = base + (size_t)(ai * HALF + m * 16) * 1024;
#pragma unroll
                for (int bj = 0; bj < 2; ++bj) { *(f32x4*)(rowp + bj * HALF) = acc[ai][bj][m][0]; *(f32x4*)(rowp + bj * HALF + 4) = acc[ai][bj][m][1]; } }
    }
};

struct OneUnit {
    StaticOrder S; int round;
    __device__ __forceinline__ bool next(int i, Unit& u) const { return (i == 0) ? S.next(round, u) : false; }
    __device__ __forceinline__ void a_ready(const Unit&) const {}
    __device__ __forceinline__ void done(const Unit&) const {}
};
struct RmsStats {
    float* xbuf;
    unsigned* cnt;
    __device__ __forceinline__ void run(const f32x4 (&v)[2][2][4][2], const Unit& u, int wr, int wc, int fr, int fq, PG8_LAS unsigned char* lds, int wid, int lane) const {
        PG8_LAS float* P = (PG8_LAS float*)lds;
        PG8_LAS float* S = (PG8_LAS float*)(lds + 8192);
        const int a16 = ((lane ^ 16) << 2), a32 = ((lane ^ 32) << 2);
#pragma unroll
        for (int ai = 0; ai < 2; ++ai)
#pragma unroll
            for (int m = 0; m < 4; ++m) {
                float s = 0.f;
#pragma unroll
                for (int bj = 0; bj < 2; ++bj)
#pragma unroll
                    for (int n = 0; n < 2; ++n) { const f32x4 x = v[ai][bj][m][n]; s += (x[0] * x[0] + x[1] * x[1]) + (x[2] * x[2] + x[3] * x[3]); }
                s += __builtin_bit_cast(float, __builtin_amdgcn_ds_bpermute(a16, __builtin_bit_cast(int, s)));
                s += __builtin_bit_cast(float, __builtin_amdgcn_ds_bpermute(a32, __builtin_bit_cast(int, s)));
                if (fq == 0) P[(ai * HALF + wr * 64 + m * 16 + fr) * 4 + wc] = s;
            }
        asm volatile("s_waitcnt lgkmcnt(0)" ::: "memory"); __builtin_amdgcn_s_barrier(); asm volatile("" ::: "memory");
        const int row = wid * 32 + (lane & 31);
        if (lane < 32) { const float t = (P[row * 4 + 0] + P[row * 4 + 1]) + (P[row * 4 + 2] + P[row * 4 + 3]);
            __hip_atomic_store(xbuf + ((size_t)(u.pm * BM + row) * 4 + u.pn), t, __ATOMIC_RELAXED, __HIP_MEMORY_SCOPE_AGENT); }
        asm volatile("s_waitcnt vmcnt(0)" ::: "memory");
        if (lane == 0) __hip_atomic_fetch_add(cnt + 64 * u.pm, 1u, __ATOMIC_RELAXED, __HIP_MEMORY_SCOPE_AGENT);
        if (wid == 0) {
            unsigned spins = 0;
            while ((unsigned)__builtin_amdgcn_readfirstlane(__hip_atomic_load(cnt + 64 * u.pm, __ATOMIC_RELAXED, __HIP_MEMORY_SCOPE_AGENT)) < 32u) { __builtin_amdgcn_s_sleep(2); if (++spins > (1u << 24)) break; }
            __builtin_amdgcn_fence(__ATOMIC_ACQUIRE, "agent");
        }
        asm volatile("s_waitcnt vmcnt(0) lgkmcnt(0)" ::: "memory"); __builtin_amdgcn_s_barrier(); asm volatile("" ::: "memory");
        if (lane < 32) { const float* slot = xbuf + (size_t)(u.pm * BM + row) * 4; float t = 0.f;
#pragma unroll
            for (int k = 0; k < 4; ++k) t += __hip_atomic_load(slot + k, __ATOMIC_RELAXED, __HIP_MEMORY_SCOPE_AGENT);
            S[row] = t; }
        asm volatile("s_waitcnt vmcnt(0) lgkmcnt(0)" ::: "memory"); __builtin_amdgcn_s_barrier(); asm volatile("" ::: "memory");
    }
};
struct EpiRms2 {
    static constexpr bool PERM = false, AFTER_DRAIN = true;
    const void* base; int base_mode; const float* g_prev; const float* rstd_prev; float* out; bf16_t* xn; float* rstd_out; const float* ga; const float* gb; float scale; RmsStats st1, st2; const float* rsc;
    __device__ __forceinline__ void operator()(const f32x4 (&)[2][2][4][2], const Unit&, int, int, int, int) const {}
    __device__ __forceinline__ void kscale(f32x4 (&acc)[2][2][4][2], const Unit& u, int t, int wr, int fr) const {
        const int sel = (t == 6) ? 0 : ((t == 10) ? 1 : 2);
#pragma unroll
        for (int ai = 0; ai < 2; ++ai)
#pragma unroll
            for (int m = 0; m < 4; ++m) { const float f = rsc[(size_t)(u.pm * BM + ai * HALF + wr * 64 + m * 16 + fr) * 4 + sel];
#pragma unroll
                for (int bj = 0; bj < 2; ++bj)
#pragma unroll
                    for (int n = 0; n < 2; ++n) acc[ai][bj][m][n] = acc[ai][bj][m][n] * f; }
    }
    __device__ __forceinline__ void fused(f32x4 (&acc)[2][2][4][2], const Unit& u, int wr, int wc, int fr, int fq, PG8_LAS unsigned char* lds, int wid, int lane) const {
        typedef unsigned u32x2v __attribute__((ext_vector_type(2)));
        const PG8_LAS float* S = (const PG8_LAS float*)(lds + 8192);
        const int col0 = u.pn * BM + wc * 32 + 4 * fq;
        if (rsc) kscale(acc, u, -1, wr, fr);
        st1.run(acc, u, wr, wc, fr, fq, lds, wid, lane);
#pragma unroll
        for (int ai = 0; ai < 2; ++ai)
#pragma unroll
            for (int m = 0; m < 4; ++m) { const int r = ai * HALF + wr * 64 + m * 16 + fr; const float rs = scale * __builtin_amdgcn_rsqf(S[r] * (1.0f / 1024.0f) + 1e-6f); const size_t off = (size_t)(u.pm * BM + r) * 1024 + col0;
                const float binv = base_mode ? __builtin_amdgcn_rcpf(rstd_prev[u.pm * BM + r]) : 1.f;
#pragma unroll
                for (int bj = 0; bj < 2; ++bj)
#pragma unroll
                    for (int n = 0; n < 2; ++n) { f32x4 bs;
                        if (base_mode) { const u32x2v w = *(const u32x2v*)((const bf16_t*)base + off + bj * HALF + n * 16); const f32x4 gp = *(const f32x4*)(g_prev + col0 + bj * HALF + n * 16);
                            bs = (f32x4){__builtin_bit_cast(float, w.x << 16) * __builtin_amdgcn_rcpf(gp[0]), __builtin_bit_cast(float, w.x & 0xffff0000u) * __builtin_amdgcn_rcpf(gp[1]),
                                         __builtin_bit_cast(float, w.y << 16) * __builtin_amdgcn_rcpf(gp[2]), __builtin_bit_cast(float, w.y & 0xffff0000u) * __builtin_amdgcn_rcpf(gp[3])} * binv; }
                        else bs = *(const f32x4*)((const float*)base + off + bj * HALF + n * 16);
                        const f32x4 g = *(const f32x4*)(ga + col0 + bj * HALF + n * 16); acc[ai][bj][m][n] = bs + acc[ai][bj][m][n] * g * rs; }
                asm volatile("" : "+v"(acc[ai][0][m][0]), "+v"(acc[ai][0][m][1]), "+v"(acc[ai][1][m][0]), "+v"(acc[ai][1][m][1]));
                if (m & 1) asm volatile("" ::: "memory"); }
        if (gb) st2.run(acc, u, wr, wc, fr, fq, lds, wid, lane);
#pragma unroll
        for (int ai = 0; ai < 2; ++ai)
#pragma unroll
            for (int m = 0; m < 4; ++m) { const int r = ai * HALF + wr * 64 + m * 16 + fr; const size_t off = (size_t)(u.pm * BM + r) * 1024 + col0;
                const float rs2 = gb ? __builtin_amdgcn_rsqf(S[r] * (1.0f / 1024.0f) + 1e-6f) : 0.f;
                if (gb && u.pn == 0 && wc == 0 && fq == 0) rstd_out[u.pm * BM + r] = rs2;
#pragma unroll
                for (int bj = 0; bj < 2; ++bj)
#pragma unroll
                    for (int n = 0; n < 2; ++n) { const f32x4 x1 = acc[ai][bj][m][n];
                        if (out) __builtin_nontemporal_store(x1, (f32x4*)(out + off + bj * HALF + n * 16));
                        if (gb) { const f32x4 g = *(const f32x4*)(gb + col0 + bj * HALF + n * 16); const f32x4 o = x1 * g * rs2; u32x2v w; w.x = cvt_pk_bf16(o[0], o[1]); w.y = cvt_pk_bf16(o[2], o[3]); *(u32x2v*)(xn + off + bj * HALF + n * 16) = w; } }
                asm volatile("" ::: "memory"); }
    }
};
template <class Epi, class Sched, bool ALIGN_EPI = false, bool SP2 = false, bool KSCALE = false>
__device__ __forceinline__ void gemm_phase(PG8_LAS unsigned char* lds, const Gemm g, const Sched& S, const Epi& E, int tid_in) {
    int tid_ = tid_in; asm volatile("" : "+v"(tid_));
    const int tid = tid_, wid = __builtin_amdgcn_readfirstlane(tid >> 6), lane = tid & 63, wr = wid >> 2, wc = wid & 3, fr = lane & 15, fq = lane >> 4;
    const int K = g.ld, nt = g.K / BK;
    unsigned voffA[2], voffB[2];
#pragma unroll
    for (int i = 0; i < 2; ++i) { int R, C; stage_rc(tid * 16 + i * 8192, R, C); const int Rb = Epi::PERM ? ((R & ~31) + perm32(R & 31)) : R;
        voffA[i] = (unsigned)(R * K + C) * 2u; voffB[i] = (unsigned)(Rb * K + C) * 2u; }
    const size_t kstep = (size_t)(BK * 2);
    const size_t hstep = (size_t)HALF * K * 2;
    const size_t tstep = 2 * hstep;
    const unsigned ldsw = (unsigned)wid * 1024u;
    const int aoff = lds_byte(wr * 64 + fr, fq * 8), boff = lds_byte(wc * 32 + fr, fq * 8);
#define PG8_SA(b, h) (((b) * 2 + (h)) * HTB)
#define PG8_SB(b, h) ((4 + (b) * 2 + (h)) * HTB)
#define PG8_STAGE(bufoff, gbase, voff) do { _Pragma("unroll") for (int _i = 0; _i < 2; ++_i) \
        __builtin_amdgcn_global_load_lds((const unsigned*)((const char*)(gbase) + (voff)[_i]), (PG8_LAS unsigned*)(lds + (bufoff) + ldsw + _i * 8192), 16, 0, 0); } while (0)
#define PG8_LDA(dst, b, h) do { _Pragma("unroll") for (int m = 0; m < 4; ++m) _Pragma("unroll") for (int k = 0; k < 2; ++k) dst[m][k] = *(const PG8_LAS bf16x8*)(lds + PG8_SA(b, h) + aoff + m * 2048 + k * 1024); } while (0)
#define PG8_LDB(dst, b, h) do { _Pragma("unroll") for (int n = 0; n < 2; ++n) _Pragma("unroll") for (int k = 0; k < 2; ++k) dst[n][k] = *(const PG8_LAS bf16x8*)(lds + PG8_SB(b, h) + boff + n * 2048 + k * 1024); } while (0)
#define PG8_MMA(ai, bj, At, Bt) do { __builtin_amdgcn_s_setprio(1); _Pragma("unroll") for (int m = 0; m < 4; ++m) _Pragma("unroll") for (int n = 0; n < 2; ++n) _Pragma("unroll") for (int k = 0; k < 2; ++k) \
        acc[ai][bj][m][n] = __builtin_amdgcn_mfma_f32_16x16x32_bf16(Bt[n][k], At[m][k], acc[ai][bj][m][n], 0, 0, 0); __builtin_amdgcn_s_setprio(0); } while (0)
#define PG8_WAIT_V(n) asm volatile("s_waitcnt vmcnt(" #n ")" ::: "memory")
#define PG8_WAIT_L(n) asm volatile("s_waitcnt lgkmcnt(" #n ")" ::: "memory")
#define PG8_BAR __builtin_amdgcn_s_barrier()
#define PG8_SCHED __builtin_amdgcn_sched_barrier(0)
    Unit cur, nxt; int ui = 0;
    if (!S.next(0, cur)) return;
    f32x4 acc[2][2][4][2];
#pragma unroll
    for (int a = 0; a < 2; ++a)
#pragma unroll
        for (int b = 0; b < 2; ++b)
#pragma unroll
            for (int m = 0; m < 4; ++m)
#pragma unroll
                for (int n = 0; n < 2; ++n) acc[a][b][m][n] = (f32x4){0.f, 0.f, 0.f, 0.f};
    bf16x8 At[4][2], B0[2][2], B1[2][2];
    const char* cA = (const char*)g.A + (size_t)cur.pm * tstep + (size_t)cur.kofs * 2; const char* cB = (const char*)g.Bt + (size_t)cur.pn * tstep + (size_t)cur.kofs * 2;
    S.a_ready(cur);
    if constexpr (SP2) {
        PG8_STAGE(PG8_SB(0, 0), cB, voffB); PG8_STAGE(PG8_SB(0, 1), cB + hstep, voffB); PG8_STAGE(PG8_SA(0, 0), cA, voffA); PG8_STAGE(PG8_SA(0, 1), cA + hstep, voffA);
        if (wr == 1) PG8_BAR;
        PG8_WAIT_V(2); PG8_BAR;
        PG8_STAGE(PG8_SB(1, 0), cB + kstep, voffB); PG8_STAGE(PG8_SA(1, 0), cA + kstep, voffA); PG8_STAGE(PG8_SB(1, 1), cB + hstep + kstep, voffB);
        PG8_WAIT_V(6); PG8_BAR;
    } else {
        PG8_STAGE(PG8_SB(0, 0), cB, voffB); PG8_STAGE(PG8_SA(0, 0), cA, voffA); PG8_STAGE(PG8_SB(0, 1), cB + hstep, voffB); PG8_STAGE(PG8_SA(0, 1), cA + hstep, voffA);
        if (wr == 1) PG8_BAR;
        PG8_WAIT_V(4); PG8_BAR;
        PG8_STAGE(PG8_SB(1, 0), cB + kstep, voffB); PG8_STAGE(PG8_SA(1, 0), cA + kstep, voffA); PG8_STAGE(PG8_SB(1, 1), cB + hstep + kstep, voffB);
        PG8_WAIT_V(6); PG8_BAR;
    }
    for (;;) {
        const bool has_next = S.next(ui + 1, nxt);
        const char* nA = has_next ? (const char*)g.A + (size_t)nxt.pm * tstep + (size_t)nxt.kofs * 2 : cA; const char* nB = has_next ? (const char*)g.Bt + (size_t)nxt.pn * tstep + (size_t)nxt.kofs * 2 : cB;
        for (int t = 0; t < nt; t += 2) {
            const bool last = (t == nt - 2);
            const char* a1 = cA + (size_t)(t + 1) * kstep;
            const char* a2 = last ? nA : cA + (size_t)(t + 2) * kstep; const char* b2 = last ? nB : cB + (size_t)(t + 2) * kstep;
            const char* a3 = a2 + kstep; const char* b3 = b2 + kstep;
            if (last && has_next) S.a_ready(nxt);
            if constexpr (KSCALE) { if (t == 6 || t == 10) E.kscale(acc, cur, t, wr, fr); }
            if constexpr (SP2) {
            PG8_LDB(B0, 0, 0); PG8_LDB(B1, 0, 1); PG8_SCHED; PG8_LDA(At, 0, 0); PG8_STAGE(PG8_SA(1, 1), a1 + hstep, voffA);
            PG8_WAIT_V(8); PG8_WAIT_L(0); PG8_BAR; PG8_MMA(0, 0, At, B0); PG8_MMA(0, 1, At, B1); PG8_BAR; PG8_SCHED;
            PG8_LDA(At, 0, 1); PG8_STAGE(PG8_SB(0, 0), b2, voffB); PG8_STAGE(PG8_SB(0, 1), b2 + hstep, voffB); PG8_STAGE(PG8_SA(0, 0), a2, voffA);
            PG8_WAIT_V(8); PG8_WAIT_L(0); PG8_BAR; PG8_MMA(1, 0, At, B0); PG8_MMA(1, 1, At, B1); PG8_BAR; PG8_SCHED;
            PG8_LDB(B0, 1, 0); PG8_LDB(B1, 1, 1); PG8_SCHED; PG8_LDA(At, 1, 0); PG8_STAGE(PG8_SA(0, 1), a2 + hstep, voffA);
            PG8_WAIT_V(8); PG8_WAIT_L(0); PG8_BAR; PG8_MMA(0, 0, At, B0); PG8_MMA(0, 1, At, B1); PG8_BAR; PG8_SCHED;
            PG8_LDA(At, 1, 1); PG8_STAGE(PG8_SB(1, 0), b3, voffB); PG8_STAGE(PG8_SB(1, 1), b3 + hstep, voffB); PG8_STAGE(PG8_SA(1, 0), a3, voffA);
            PG8_WAIT_V(8); PG8_WAIT_L(0); PG8_BAR; PG8_MMA(1, 0, At, B0); PG8_MMA(1, 1, At, B1); PG8_BAR; PG8_SCHED;
            } else {
            PG8_LDB(B0, 0, 0); PG8_SCHED; PG8_LDA(At, 0, 0); PG8_STAGE(PG8_SA(1, 1), a1 + hstep, voffA);
            PG8_WAIT_L(8); PG8_BAR; PG8_WAIT_L(0); PG8_MMA(0, 0, At, B0); PG8_BAR; PG8_SCHED;
            PG8_LDB(B1, 0, 1); PG8_STAGE(PG8_SB(0, 0), b2, voffB);
            PG8_BAR; PG8_WAIT_L(0); PG8_MMA(0, 1, At, B1); PG8_BAR;
            PG8_LDA(At, 0, 1); PG8_STAGE(PG8_SA(0, 0), a2, voffA);
            PG8_BAR; PG8_WAIT_L(0); PG8_MMA(1, 0, At, B0); PG8_BAR; PG8_SCHED;
            PG8_STAGE(PG8_SB(0, 1), b2 + hstep, voffB);
            PG8_WAIT_V(6); PG8_BAR; PG8_MMA(1, 1, At, B1); PG8_BAR;
            PG8_LDB(B0, 1, 0); PG8_SCHED; PG8_LDA(At, 1, 0); PG8_STAGE(PG8_SA(0, 1), a2 + hstep, voffA);
            PG8_WAIT_L(8); PG8_BAR; PG8_WAIT_L(0); PG8_MMA(0, 0, At, B0); PG8_BAR; PG8_SCHED;
            PG8_LDB(B1, 1, 1); PG8_STAGE(PG8_SB(1, 0), b3, voffB);
            PG8_BAR; PG8_WAIT_L(0); PG8_MMA(0, 1, At, B1); PG8_BAR;
            PG8_LDA(At, 1, 1); PG8_STAGE(PG8_SA(1, 0), a3, voffA);
            PG8_BAR; PG8_WAIT_L(0); PG8_MMA(1, 0, At, B0); PG8_BAR; PG8_SCHED;
            PG8_STAGE(PG8_SB(1, 1), b3 + hstep, voffB);
            PG8_WAIT_V(6); PG8_BAR; PG8_MMA(1, 1, At, B1); PG8_BAR;
            }
        }
        if constexpr (ALIGN_EPI) { if (wr == 0) PG8_BAR; }
        if constexpr (!Epi::AFTER_DRAIN) { E(acc, cur, wr, wc, fr, fq); S.done(cur); }
        if (!has_next) break;
#pragma unroll
        for (int a = 0; a < 2; ++a)
#pragma unroll
            for (int b = 0; b < 2; ++b)
#pragma unroll
                for (int m = 0; m < 4; ++m)
#pragma unroll
                    for (int n = 0; n < 2; ++n) acc[a][b][m][n] = (f32x4){0.f, 0.f, 0.f, 0.f};
        cur = nxt; cA = nA; cB = nB; ++ui;
        if constexpr (ALIGN_EPI) { if (wr == 1) PG8_BAR; }
    }
    PG8_WAIT_V(0);
    if constexpr (!ALIGN_EPI) { if (wr == 0) PG8_BAR; }
    PG8_BAR;
    if constexpr (Epi::AFTER_DRAIN) { E.fused(acc, cur, wr, wc, fr, fq, lds, wid, lane); S.done(cur); }
#undef PG8_SA
#undef PG8_SB
#undef PG8_STAGE
#undef PG8_LDA
#undef PG8_LDB
#undef PG8_MMA
#undef PG8_WAIT_V
#undef PG8_WAIT_L
#undef PG8_BAR
#undef PG8_SCHED
}
}

#ifndef PHMASK
#define PHMASK 0xffffffffu
#endif
constexpr unsigned PHM = PHMASK;
constexpr int NWAVES = 8, NTHREADS = 512;
constexpr int DM = 1024, TP = 32768, TS = 256, TT = TP + TS;
constexpr int DFF = 2816, DIN = 2048;
constexpr int QROWS = TP + 8 * 544;
constexpr float EPSN = 1e-6f, LOG2E = 1.4426950408889634f;
constexpr size_t O_YP = 0, O_YS = 33554432, O_AKP = 33816576, O_AVP = 35389440, O_CKP = 36962304, O_CVP = 37093376, O_SRP = 37224448, O_SIP = 37232640,
                 O_AKS = 37240832, O_AVS = 40386560, O_CKS = 43532288, O_CVS = 43794432, O_SRS = 44056576, O_SIS = 44072960;
constexpr size_t MiB = 1u << 20;
constexpr size_t WS_ROPE = 0, WS_LAM = 1 * MiB, WS_L64 = WS_LAM + 32768, WS_BBB = WS_L64 + 32768, WS_CCB = WS_BBB + 524288;
constexpr size_t WS_SSH = 2 * MiB, WS_SLOC = 5 * MiB;
constexpr size_t WS_WUP = 10 * MiB, WS_WDN = 54 * MiB, WS_WIN = 76 * MiB, WS_WOUT = 84 * MiB, WS_WGLU = 88 * MiB;
constexpr size_t WS_XN = 89 * MiB, WS_OUT = 154 * MiB, WS_MIX = 219 * MiB, WS_YB = 284 * MiB, WS_ACT = 301 * MiB, WS_QKV = WS_ACT, WS_PART = 480 * MiB, WS_XBUF = 492 * MiB, WS_SSB = 498 * MiB, WS_RS = WS_SSB + 1536 * 1024, WS_RSTD = WS_RS + 768 * 1024, WS_END = 501 * MiB;
static_assert(WS_CCB + 131072 <= WS_SSH && WS_SSH + (size_t)TT * 16 * 4 <= WS_SLOC && WS_SLOC + 4 * MiB <= WS_WUP, "ws small region");
static_assert(WS_ACT + (size_t)TT * DFF * 2 <= WS_END && WS_QKV + (size_t)(QROWS + 64) * DIN * 2 <= WS_END, "ws big region");
constexpr int LDS_BYTES = 147456, WAVE_LDS = 17408, TAB_OFF = NWAVES * WAVE_LDS;

#define GAS __attribute__((address_space(1)))
#define LAS __attribute__((address_space(3)))
typedef unsigned short bf16;
typedef unsigned v4u __attribute__((ext_vector_type(4)));
typedef unsigned v2u __attribute__((ext_vector_type(2)));
typedef float f32x4 __attribute__((ext_vector_type(4)));
typedef float f32x2 __attribute__((ext_vector_type(2)));
typedef short bf16x8 __attribute__((ext_vector_type(8)));
typedef short s16x4 __attribute__((ext_vector_type(4)));
typedef short v4i16_t __attribute__((ext_vector_type(4)));
#define LDS_WAIT() asm volatile("s_waitcnt lgkmcnt(0)" ::: "memory")
#define CFENCE() asm volatile("" ::: "memory")
__device__ __forceinline__ unsigned f2bf(float f) { unsigned u = __builtin_bit_cast(unsigned, f); return (u + 0x7fffu + ((u >> 16) & 1u)) >> 16; }
typedef __bf16 bf16x2_t __attribute__((ext_vector_type(2)));
__device__ __forceinline__ unsigned pk2(float lo, float hi) { const f32x2 v = {lo, hi}; const bf16x2_t b = __builtin_convertvector(v, bf16x2_t); return __builtin_bit_cast(unsigned, b); }
__device__ __forceinline__ float bflo(unsigned w) { return __builtin_bit_cast(float, w << 16); }
__device__ __forceinline__ float bfhi(unsigned w) { return __builtin_bit_cast(float, w & 0xffff0000u); }
__device__ __forceinline__ float shx(float v, int mask, int lane) { return __builtin_bit_cast(float, __builtin_amdgcn_ds_bpermute((lane ^ mask) << 2, __builtin_bit_cast(int, v))); }
__device__ __forceinline__ float wave_sum(float v, int lane) {
#pragma unroll
    for (int o = 1; o < 64; o <<= 1) v += shx(v, o, lane);
    return v;
}
__device__ __forceinline__ s16x4 vtr(const LAS unsigned char* p) { return __builtin_bit_cast(s16x4, __builtin_amdgcn_ds_read_tr16_b64_v4i16((LAS v4i16_t*)p)); }

struct Args { const float* in[25]; float* out; unsigned char* ws; int ph_lo, ph_hi, li, pad; };

#define XB_TMO      128
#define XB_XCNT(j)  (256  + 64 * (j))
#define XB_XSUB(j)  (1280 + 64 * (j))
#define XB_XGEN(j)  (2304 + 64 * (j))
#define XB_TOP      3328
#define XB_TOPGEN   3392
#define XCD_BAR_WORDS 4096
#define XB_SPIN_CAP (1u << 22)
__device__ __forceinline__ unsigned xb_ld(unsigned* p)              { return __hip_atomic_load(p, __ATOMIC_RELAXED, __HIP_MEMORY_SCOPE_AGENT); }
__device__ __forceinline__ unsigned xb_add(unsigned* p, unsigned v) { return __hip_atomic_fetch_add(p, v, __ATOMIC_RELAXED, __HIP_MEMORY_SCOPE_AGENT); }
__device__ __forceinline__ unsigned xb_xcc_id() { return (unsigned)__builtin_amdgcn_s_getreg((3 << 11) | 20) & 0xFu; }
#define XB_SPIN(cond, bar) do { unsigned _sp = 0; while (cond) { __builtin_amdgcn_s_sleep(1); \
    if ((++_sp & 255u) == 0u) { if (xb_ld(&(bar)[XB_TMO])) break; if (_sp > XB_SPIN_CAP) { atomicAdd(&(bar)[XB_TMO], 1u); break; } } } } while (0)
__device__ __forceinline__ void xcd_barrier_complete(unsigned* bar, unsigned x, unsigned G, unsigned& nloc, unsigned& nx) {
    unsigned sum, cnt, mine, sp = 0u;
    for (;;) {
        sum = 0u; cnt = 0u; mine = 0u;
#pragma unroll
        for (unsigned j = 0; j < 16; ++j) { const unsigned c = xb_ld(&bar[XB_XCNT(j)]); sum += c; cnt += (c > 0u) ? 1u : 0u; mine = (j == x) ? c : mine; }
        if (sum == G) break;
        __builtin_amdgcn_s_sleep(1);
        if ((++sp & 255u) == 0u) { if (xb_ld(&bar[XB_TMO])) break; if (sp > XB_SPIN_CAP) { atomicAdd(&bar[XB_TMO], 1u); break; } }
    }
    nloc = mine > 0u ? mine : 1u; nx = cnt > 0u ? cnt : 1u;
}
__device__ __forceinline__ void xcd_barrier(unsigned* bar, unsigned x, unsigned G, volatile LAS unsigned* st, int tid) {
    asm volatile("s_waitcnt vmcnt(0) lgkmcnt(0)" ::: "memory");
    __syncthreads();
    if (tid == 0) {
        __builtin_amdgcn_s_waitcnt(0);
        unsigned nloc = st[0], nx = st[1];
        if (nloc == 0u) { xcd_barrier_complete(bar, x, G, nloc, nx); st[0] = nloc; st[1] = nx; }
        const unsigned old = xb_add(&bar[XB_XSUB(x)], 1u);
        const unsigned gen = old / nloc;
        if (old + 1u == (gen + 1u) * nloc) {
            __builtin_amdgcn_fence(__ATOMIC_RELEASE, "agent");
            asm volatile("s_waitcnt vmcnt(0)" ::: "memory");
            const unsigned og = xb_add(&bar[XB_TOP], 1u);
            const unsigned tg = og / nx;
            if (og + 1u == (tg + 1u) * nx) xb_add(&bar[XB_TOPGEN], 1u);
            else XB_SPIN(xb_ld(&bar[XB_TOPGEN]) == tg, bar);
            __builtin_amdgcn_fence(__ATOMIC_ACQUIRE, "agent");
            xb_add(&bar[XB_XGEN(x)], 1u);
            asm volatile("s_waitcnt vmcnt(0)" ::: "memory");
        } else {
            XB_SPIN(xb_ld(&bar[XB_XGEN(x)]) == gen, bar);
            __builtin_amdgcn_fence(__ATOMIC_ACQUIRE, "agent");
            asm volatile("s_waitcnt vmcnt(0)" ::: "memory");
        }
    }
    __syncthreads();
}
__device__ __forceinline__ int lane_id_v() { int r; asm volatile("v_mbcnt_lo_u32_b32 %0, -1, 0\n\tv_mbcnt_hi_u32_b32 %0, -1, %0" : "=v"(r)); return r; }
constexpr size_t WS_CTL = 9 * MiB, WS_PCNT = WS_CTL + 131072;
__device__ __forceinline__ void gbar(unsigned* ctr, unsigned target, int tid) {
    asm volatile("s_waitcnt vmcnt(0) lgkmcnt(0)" ::: "memory");
    __syncthreads();
    if (tid == 0) {
        __builtin_amdgcn_fence(__ATOMIC_RELEASE, "agent");
        asm volatile("s_waitcnt vmcnt(0)" ::: "memory");
        __hip_atomic_fetch_add(ctr, 1u, __ATOMIC_RELAXED, __HIP_MEMORY_SCOPE_AGENT);
        while (__hip_atomic_load(ctr, __ATOMIC_RELAXED, __HIP_MEMORY_SCOPE_AGENT) < target) __builtin_amdgcn_s_sleep(2);
        __builtin_amdgcn_fence(__ATOMIC_ACQUIRE, "agent");
        asm volatile("s_waitcnt vmcnt(0)" ::: "memory");
    }
    __syncthreads();
}
constexpr int PTAB_OFF = LDS_BYTES - 512;
__device__ __forceinline__ const float* inptr(LAS unsigned char* lds, int k) { const LAS unsigned* t = (const LAS unsigned*)(lds + PTAB_OFF) + 2 * k;
    const unsigned lo = __builtin_amdgcn_readfirstlane(t[0]), hi = __builtin_amdgcn_readfirstlane(t[1]); return (const float*)(((unsigned long long)hi << 32) | lo); }

__device__ __forceinline__ void transpose_item(const float* __restrict__ W, int K, int N, bf16* WT, int dst_row0, int k0, int n0, const float* kscale, LAS float* scr, int lane, bool ropeperm = false) {
#pragma unroll
    for (int i = 0; i < 8; ++i) { const int kk = 8 * i + (lane >> 3), n4 = (lane & 7) * 4; f32x4 v = __builtin_nontemporal_load((const f32x4*)(W + (size_t)(k0 + kk) * N + n0 + n4));     if (kscale) v = v * kscale[k0 + kk];
        scr[kk * 33 + n4] = v.x; scr[kk * 33 + n4 + 1] = v.y; scr[kk * 33 + n4 + 2] = v.z; scr[kk * 33 + n4 + 3] = v.w; }
    LDS_WAIT();
    const int c = lane & 7;
#pragma unroll
    for (int j = 0; j < 4; ++j) { const int n = (lane >> 3) + 8 * j; const LAS float* s = scr + (8 * c) * 33 + n;
        const int nd = (ropeperm && n < 16) ? (8 * ((n >> 2) & 1) + 2 * (n & 3) + ((n >> 3) & 1)) : n;
        v4u o; o.x = pk2(s[0 * 33], s[1 * 33]); o.y = pk2(s[2 * 33], s[3 * 33]); o.z = pk2(s[4 * 33], s[5 * 33]); o.w = pk2(s[6 * 33], s[7 * 33]);
        *(v4u*)(WT + (size_t)(dst_row0 + nd) * K + k0 + 8 * c) = o; }
    LDS_WAIT();
}
__device__ __forceinline__ int glu_row(int n0, int half) { const int j = (n0 < half) ? n0 : n0 - half; return (j >> 7) * 256 + (j & 127) + ((n0 < half) ? 0 : 128); }

struct RowIn { f32x4 v[4]; f32x4 o[4]; };
__device__ __forceinline__ void row_load(RowIn& r, const float* xin, const bf16* OUT, int lane, const float* part, int nks) {
#pragma unroll
    for (int j = 0; j < 4; ++j) r.v[j] = ((const f32x4*)xin)[lane + 64 * j];
    if (OUT) {
#pragma unroll
        for (int j = 0; j < 4; ++j) { if (part) { f32x4 a0 = (f32x4){0.f, 0.f, 0.f, 0.f}, a1 = a0, a2 = a0, a3 = a0; int ks = 0;
                for (; ks + 4 <= nks; ks += 4) { const f32x4* pp = (const f32x4*)(part + (size_t)ks * 262144) + lane + 64 * j; const f32x4 b0 = pp[0], b1 = pp[65536], b2 = pp[131072], b3 = pp[196608]; a0 = a0 + b0; a1 = a1 + b1; a2 = a2 + b2; a3 = a3 + b3; }
                for (; ks < nks; ++ks) a0 = a0 + ((const f32x4*)(part + (size_t)ks * 262144))[lane + 64 * j];
                r.o[j] = (a0 + a1) + (a2 + a3); }
            else { const v2u w = ((const v2u*)OUT)[lane + 64 * j]; r.o[j] = (f32x4){bflo(w.x), bfhi(w.x), bflo(w.y), bfhi(w.y)}; } }
    }
}
__device__ __forceinline__ void row_finish(RowIn& r, float* X, bool has_out, const float* ga, float scale, bf16* XN, const float* gb, int lane) {
    if (has_out) {
        float s = 0.f;
#pragma unroll
        for (int j = 0; j < 4; ++j) s += (r.o[j].x * r.o[j].x + r.o[j].y * r.o[j].y) + (r.o[j].z * r.o[j].z + r.o[j].w * r.o[j].w);
        const float rs = scale * __builtin_amdgcn_rsqf(wave_sum(s, lane) * (1.f / DM) + EPSN);
#pragma unroll
        for (int j = 0; j < 4; ++j) { const f32x4 g = ((const f32x4*)ga)[lane + 64 * j]; r.v[j] = r.v[j] + r.o[j] * g * rs; }
    }
    if (X) {
#pragma unroll
        for (int j = 0; j < 4; ++j) ((f32x4*)X)[lane + 64 * j] = r.v[j]; }
    if (gb) {
        float s = 0.f;
#pragma unroll
        for (int j = 0; j < 4; ++j) s += (r.v[j].x * r.v[j].x + r.v[j].y * r.v[j].y) + (r.v[j].z * r.v[j].z + r.v[j].w * r.v[j].w);
        const float rs = __builtin_amdgcn_rsqf(wave_sum(s, lane) * (1.f / DM) + EPSN);
#pragma unroll
        for (int j = 0; j < 4; ++j) { const f32x4 g = ((const f32x4*)gb)[lane + 64 * j]; const f32x4 y = r.v[j] * g * rs; v2u w; w.x = pk2(y.x, y.y); w.y = pk2(y.z, y.w); ((v2u*)XN)[lane + 64 * j] = w; }
    }
}
__device__ __forceinline__ void row_pass(const float* xin, float* X, const bf16* OUT, const float* ga, float scale, bf16* XN, const float* gb, int lane, const float* part = nullptr, int nks = 0) {
    RowIn r; row_load(r, xin, OUT, lane, part, nks); row_finish(r, X, OUT != nullptr, ga, scale, XN, gb, lane);
}
__device__ __forceinline__ void post_rows(const float* xbase  , const float* x_p_, const float* x_s_, float* X, const bf16* OUTB_, const float* partbase, int nks, const float* ga, float scale, bf16* XN_, const float* gb, int gw, int NGW, int lane, int mmin = 0) {
    for (int m0 = TT - 1 - gw; m0 >= mmin; m0 -= 4 * NGW) {
        RowIn r[4];
#pragma unroll
        for (int q = 0; q < 4; ++q) { const int m = m0 - q * NGW; if (m >= mmin) {
            const float* xin = xbase ? xbase + (size_t)m * DM : ((m < TP) ? x_p_ + (size_t)m * DM : x_s_ + (size_t)(m - TP) * DM);
            row_load(r[q], xin, OUTB_ + (size_t)m * DM, lane, (m >= TP) ? partbase + (size_t)(m - TP) * DM : nullptr, nks); } }
#pragma unroll
        for (int q = 0; q < 4; ++q) { const int m = m0 - q * NGW; if (m >= mmin) row_finish(r[q], X + (size_t)m * DM, true, ga, scale, XN_ ? XN_ + (size_t)m * DM : nullptr, gb, lane); }
    }
}

struct MixIn { v4u w0, w1; f32x4 s0, s1, s2; };
__device__ __forceinline__ void mix_load(MixIn& r, const float* SSHp, const bf16* MIXp, int m, int lane) {
    const f32x4* sp = (const f32x4*)(SSHp + (size_t)m * 16); r.s0 = sp[0]; r.s1 = sp[1]; r.s2 = sp[2];
    const v4u* mp = (const v4u*)(MIXp + (size_t)m * DM); r.w0 = mp[lane]; r.w1 = mp[lane + 64];
}
__device__ __forceinline__ v4u mix_scale(v4u x, float r) { x.x = pk2(bflo(x.x) * r, bfhi(x.x) * r); x.y = pk2(bflo(x.y) * r, bfhi(x.y) * r); x.z = pk2(bflo(x.z) * r, bfhi(x.z) * r); x.w = pk2(bflo(x.w) * r, bfhi(x.w) * r); return x; }
__device__ __forceinline__ float mix_ss(v4u x) { const float a0 = bflo(x.x), a1 = bfhi(x.x), a2 = bflo(x.y), a3 = bfhi(x.y), a4 = bflo(x.z), a5 = bfhi(x.z), a6 = bflo(x.w), a7 = bfhi(x.w);
    return (a0 * a0 + a1 * a1) + (a2 * a2 + a3 * a3) + (a4 * a4 + a5 * a5) + (a6 * a6 + a7 * a7); }
__device__ __forceinline__ void mix_finish(const MixIn& r, bf16* MIXp, int m, bool valid, int lane) {
    const float ra = __builtin_amdgcn_rsqf(((r.s0.x + r.s0.y) + (r.s0.z + r.s0.w) + (r.s1.x + r.s1.y)) * (1.f / 384.f) + EPSN);
    const float rc = __builtin_amdgcn_rsqf(((r.s1.z + r.s1.w) + (r.s2.x + r.s2.y) + (r.s2.z + r.s2.w)) * (1.f / 384.f) + EPSN);
    float sb = 0.f;
    if (lane >= 48) sb += mix_ss(r.w0);
    if (lane < 16) sb += mix_ss(r.w1);
    const float rb = __builtin_amdgcn_rsqf(wave_sum(sb, lane) * (1.f / 256.f) + EPSN);
    v4u* mp = (v4u*)(MIXp + (size_t)m * DM);
    if (valid) { mp[lane] = mix_scale(r.w0, (lane < 48) ? ra : rb); mp[lane + 64] = mix_scale(r.w1, (lane < 16) ? rb : rc); }
}

__device__ __forceinline__ void sample_rows_after_split(unsigned* cnt, int nsub, int bid, int tid, const float* xin_base, float* X, const float* part, int nks, const float* ga, float scale, bf16* XN_, const float* gb) {
    const int lane = tid & 63, wave = __builtin_amdgcn_readfirstlane(tid >> 6);
    if (bid < nsub) {
        asm volatile("s_waitcnt vmcnt(0)" ::: "memory"); __syncthreads();
        if (tid == 0) { __builtin_amdgcn_fence(__ATOMIC_RELEASE, "agent"); asm volatile("s_waitcnt vmcnt(0)" ::: "memory"); __hip_atomic_fetch_add(cnt, 1u, __ATOMIC_RELAXED, __HIP_MEMORY_SCOPE_AGENT); }
        return;
    }
    if (bid < 224) return;
    if (tid == 0) { unsigned spins = 0;
        while (__hip_atomic_load(cnt, __ATOMIC_RELAXED, __HIP_MEMORY_SCOPE_AGENT) < (unsigned)nsub) { __builtin_amdgcn_s_sleep(16); if (++spins > (1u << 22)) break; }
        __builtin_amdgcn_fence(__ATOMIC_ACQUIRE, "agent"); asm volatile("s_waitcnt vmcnt(0)" ::: "memory"); }
    __syncthreads();
    const int r = (bid - 224) * 8 + wave, m = TP + r;
    RowIn a; row_load(a, xin_base + (size_t)r * DM, (const bf16*)part  , lane, part + (size_t)r * DM, nks);
    row_finish(a, X + (size_t)m * DM, true, ga, scale, XN_ ? XN_ + (size_t)m * DM : nullptr, gb, lane);
}

template <int NQB> __device__ __forceinline__ void attn_unit(const bf16* QKV, bf16* MIX, float* SSH, LAS unsigned char* wl, const LAS float* tab, bool has_bias,
                                          int srow0, int qpos0, int kt0, int kend, int qcol, int kcol, int vcol, int ocol, int sidx, int mixrow0, float m_init, bool has_sink, int lane) {
    const int fr = lane & 15, fq = lane >> 4; constexpr int nqb = NQB, nq = 16 * NQB;
    bf16x8 qf[NQB][2];
#pragma unroll
    for (int qb = 0; qb < NQB; ++qb) { int qr = 16 * qb + fr; qr = qr < nq ? qr : nq - 1; const bf16* qp = QKV + (size_t)(srow0 + qpos0 + qr) * DIN + qcol + 8 * fq;
        qf[qb][0] = *(const bf16x8*)qp; qf[qb][1] = *(const bf16x8*)(qp + 32); }
    f32x4 o[NQB][4]; float mrun[NQB], lrun[NQB];
#pragma unroll
    for (int qb = 0; qb < NQB; ++qb) { mrun[qb] = m_init; lrun[qb] = (has_sink && fq == 0) ? 1.f : 0.f;
#pragma unroll
        for (int db = 0; db < 4; ++db) o[qb][db] = (f32x4){0.f, 0.f, 0.f, 0.f}; }
    bf16x8 kf[4][2]; v4u vn[8];
#define ATT_LOADK(KT) do { _Pragma("unroll") for (int kb = 0; kb < 4; ++kb) { int kr = (KT) + 16 * kb + fr; kr = kr < kend ? kr : kend - 1; const bf16* kp = QKV + (size_t)(srow0 + kr) * DIN + kcol + 8 * fq; \
            kf[kb][0] = *(const bf16x8*)kp; kf[kb][1] = *(const bf16x8*)(kp + 32); } } while (0)
#define ATT_LOADV(KT) do { _Pragma("unroll") for (int i = 0; i < 8; ++i) { int kr = (KT) + 8 * i + (lane >> 3); kr = kr < kend ? kr : kend - 1; vn[i] = *(const v4u*)(QKV + (size_t)(srow0 + kr) * DIN + vcol + 8 * (lane & 7)); } } while (0)
    ATT_LOADK(kt0); ATT_LOADV(kt0);
    for (int kt = kt0; kt < kend; kt += 64) {
        CFENCE();
#pragma unroll
        for (int i = 0; i < 8; ++i) *(LAS v4u*)(wl + (8 * i + (lane >> 3)) * 144 + (lane & 7) * 16) = vn[i];
        CFENCE();
        if (kt + 64 < kend) ATT_LOADV(kt + 64);
        const bool tail = (kt + 64 > kend), far = (qpos0 - kt - 63 >= 128);
        bf16x8 pf[NQB][2];
        f32x4 s[NQB][4]; float mx[NQB];
#pragma unroll
        for (int qb = 0; qb < NQB; ++qb) if (qb < nqb) {
#pragma unroll
            for (int kb = 0; kb < 4; ++kb) { s[qb][kb] = (f32x4){0.f, 0.f, 0.f, 0.f};
                s[qb][kb] = __builtin_amdgcn_mfma_f32_16x16x32_bf16(kf[kb][0], qf[qb][0], s[qb][kb], 0, 0, 0);
                s[qb][kb] = __builtin_amdgcn_mfma_f32_16x16x32_bf16(kf[kb][1], qf[qb][1], s[qb][kb], 0, 0, 0); }
        }
#pragma unroll
        for (int qb = 0; qb < NQB; ++qb) if (qb < nqb) {
            if (has_bias) {
                if (!far) { const int rel0 = qpos0 + 16 * qb + fr - kt - 4 * fq;
#pragma unroll
                    for (int kb = 0; kb < 4; ++kb)
#pragma unroll
                        for (int j = 0; j < 4; ++j) { int rel = rel0 - 16 * kb - j; rel = rel < -128 ? -128 : (rel > 128 ? 128 : rel); s[qb][kb][j] += tab[rel + 128]; } }
            }
            if (tail) {
#pragma unroll
                for (int kb = 0; kb < 4; ++kb)
#pragma unroll
                    for (int j = 0; j < 4; ++j) if (kt + 16 * kb + 4 * fq + j >= kend) s[qb][kb][j] = -1e30f;
            }
            float m0 = fmaxf(fmaxf(fmaxf(s[qb][0][0], s[qb][0][1]), fmaxf(s[qb][0][2], s[qb][0][3])), fmaxf(fmaxf(s[qb][1][0], s[qb][1][1]), fmaxf(s[qb][1][2], s[qb][1][3])));
            mx[qb] = fmaxf(m0, fmaxf(fmaxf(fmaxf(s[qb][2][0], s[qb][2][1]), fmaxf(s[qb][2][2], s[qb][2][3])), fmaxf(fmaxf(s[qb][3][0], s[qb][3][1]), fmaxf(s[qb][3][2], s[qb][3][3]))));
        }
#pragma unroll
        for (int qb = 0; qb < NQB; ++qb) if (qb < nqb) mx[qb] = fmaxf(mx[qb], shx(mx[qb], 16, lane));
#pragma unroll
        for (int qb = 0; qb < NQB; ++qb) if (qb < nqb) mx[qb] = fmaxf(mx[qb], shx(mx[qb], 32, lane));
#pragma unroll
        for (int qb = 0; qb < NQB; ++qb) if (qb < nqb) {
            const float mnew = fmaxf(mrun[qb], mx[qb]), alpha = __builtin_amdgcn_exp2f(mrun[qb] - mnew); mrun[qb] = mnew;
            float ps = 0.f;
#pragma unroll
            for (int kb = 0; kb < 4; ++kb)
#pragma unroll
                for (int j = 0; j < 4; ++j) { const float p = __builtin_amdgcn_exp2f(s[qb][kb][j] - mnew); s[qb][kb][j] = p; ps += p; }
            lrun[qb] = lrun[qb] * alpha + ps;
#pragma unroll
            for (int db = 0; db < 4; ++db) o[qb][db] = o[qb][db] * alpha;
#pragma unroll
            for (int kh = 0; kh < 2; ++kh) { v4u w; w.x = pk2(s[qb][2 * kh][0], s[qb][2 * kh][1]); w.y = pk2(s[qb][2 * kh][2], s[qb][2 * kh][3]); w.z = pk2(s[qb][2 * kh + 1][0], s[qb][2 * kh + 1][1]); w.w = pk2(s[qb][2 * kh + 1][2], s[qb][2 * kh + 1][3]);
                pf[qb][kh] = __builtin_bit_cast(bf16x8, w); }
        }
        if (kt + 64 < kend) ATT_LOADK(kt + 64);
#pragma unroll
        for (int kh = 0; kh < 2; ++kh)
#pragma unroll
            for (int db = 0; db < 4; ++db) {
                const LAS unsigned char* vp = wl + (32 * kh + 4 * fq + (fr >> 2)) * 144 + 32 * db + 8 * (fr & 3);
                const s16x4 lo = vtr(vp), hi = vtr(vp + 16 * 144);
                const bf16x8 vf = (bf16x8){lo[0], lo[1], lo[2], lo[3], hi[0], hi[1], hi[2], hi[3]};
#pragma unroll
                for (int qb = 0; qb < NQB; ++qb) if (qb < nqb) o[qb][db] = __builtin_amdgcn_mfma_f32_16x16x32_bf16(vf, pf[qb][kh], o[qb][db], 0, 0, 0);
            }
        CFENCE();
    }
#pragma unroll
    for (int qb = 0; qb < NQB; ++qb) if (qb < nqb) {
        float l = lrun[qb]; l += shx(l, 16, lane); l += shx(l, 32, lane);
        const float inv = 1.f / l; float ss = 0.f; const int row = mixrow0 + 16 * qb + fr;
#pragma unroll
        for (int db = 0; db < 4; ++db) { const f32x4 v = o[qb][db] * inv; ss += (v.x * v.x + v.y * v.y) + (v.z * v.z + v.w * v.w);
            v2u w; w.x = pk2(v.x, v.y); w.y = pk2(v.z, v.w); *(v2u*)(MIX + (size_t)row * DM + ocol + 16 * db + 4 * fq) = w; }
        ss += shx(ss, 16, lane); ss += shx(ss, 32, lane);
        if (fq == 0) SSH[(size_t)row * 16 + sidx] = ss;
    }
}

constexpr int VSTRIDE = 528, XSTRIDE = 272, XT_OFF = 16 * VSTRIDE;
template <bool OUTPUT> __device__ __forceinline__ void ssm_unit(const bf16* QKVp, const unsigned char* ws, bf16* YBp, LAS unsigned char* wl, const float* dskip, int l, int g, int ntok, int qrow0, int yrow0,
                                                               float hr, float hi, float* fin_re, float* fin_im, int lane) {
    const int fr = lane & 15, fq = lane >> 4, lg = l * 16 + g;
    const f32x2 lam = ((const f32x2*)(ws + WS_LAM))[lg * 64 + lane];
    bf16x8 bfr[8];
#pragma unroll
    for (int pb = 0; pb < 8; ++pb) { bfr[pb] = (bf16x8){0, 0, 0, 0, 0, 0, 0, 0}; if (fq < 2) bfr[pb] = *(const bf16x8*)((const bf16*)(ws + WS_BBB) + (size_t)(lg * 128 + 16 * pb + fr) * 16 + 8 * fq); }
    bf16x8 cf[4]; f32x4 dv = (f32x4){0.f, 0.f, 0.f, 0.f};
    if (OUTPUT) {
#pragma unroll
        for (int ks = 0; ks < 4; ++ks) cf[ks] = *(const bf16x8*)((const bf16*)(ws + WS_CCB) + (size_t)(lg * 16 + fr) * 128 + 32 * ks + 8 * fq);
        dv = *(const f32x4*)(dskip + lg * 16 + 4 * fq);
    }
    float xr = hr, xi = hi;
    const int nblk = ntok >> 4;
    bf16x8 uf = (bf16x8){0, 0, 0, 0, 0, 0, 0, 0}; v2u uw = (v2u){0u, 0u};
    if (fq < 2) uf = *(const bf16x8*)(QKVp + (size_t)(qrow0 + fr) * DIN + 1152 + 16 * g + 8 * fq);
    if (OUTPUT) uw = *(const v2u*)(QKVp + (size_t)(qrow0 + fr) * DIN + 1152 + 16 * g + 4 * fq);
    for (int tb = 0; tb < nblk; ++tb) {
        const bf16x8 ucur = uf; const v2u uwc = uw;
        if (tb + 1 < nblk) {
            if (fq < 2) uf = *(const bf16x8*)(QKVp + (size_t)(qrow0 + 16 * (tb + 1) + fr) * DIN + 1152 + 16 * g + 8 * fq);
            if (OUTPUT) uw = *(const v2u*)(QKVp + (size_t)(qrow0 + 16 * (tb + 1) + fr) * DIN + 1152 + 16 * g + 4 * fq);
        }
#pragma unroll
        for (int pb = 0; pb < 8; ++pb) { f32x4 d = (f32x4){0.f, 0.f, 0.f, 0.f}; d = __builtin_amdgcn_mfma_f32_16x16x32_bf16(bfr[pb], ucur, d, 0, 0, 0);
            *(LAS f32x4*)(wl + fr * VSTRIDE + (16 * pb + 4 * fq) * 4) = d; }
        CFENCE();
#pragma unroll 4
        for (int t = 0; t < 16; ++t) {
            const float vr = *(const LAS float*)(wl + t * VSTRIDE + lane * 4), vi = *(const LAS float*)(wl + t * VSTRIDE + 256 + lane * 4);
            const float nr = lam.x * xr - lam.y * xi + vr, ni = lam.x * xi + lam.y * xr + vi; xr = nr; xi = ni;
            if (OUTPUT) { const unsigned w = pk2(xr, xi); *(LAS unsigned short*)(wl + XT_OFF + t * XSTRIDE + lane * 2) = (unsigned short)w; *(LAS unsigned short*)(wl + XT_OFF + t * XSTRIDE + 128 + lane * 2) = (unsigned short)(w >> 16); }
        }
        CFENCE();
        if (OUTPUT) {
            f32x4 acc = (f32x4){0.f, 0.f, 0.f, 0.f};
#pragma unroll
            for (int ks = 0; ks < 4; ++ks) { const bf16x8 xf = *(const LAS bf16x8*)(wl + XT_OFF + fr * XSTRIDE + (32 * ks + 8 * fq) * 2);
                acc = __builtin_amdgcn_mfma_f32_16x16x32_bf16(cf[ks], xf, acc, 0, 0, 0); }
            const f32x4 uu = (f32x4){bflo(uwc.x), bfhi(uwc.x), bflo(uwc.y), bfhi(uwc.y)};
            f32x4 y = acc + dv * uu;
#pragma unroll
            for (int j = 0; j < 4; ++j) { const float z = 0.7978845608028654f * (y[j] + 0.044715f * y[j] * y[j] * y[j]); y[j] = y[j] * __builtin_amdgcn_rcpf(1.0f + __builtin_amdgcn_exp2f(-2.f * LOG2E * z)); }
            v2u w; w.x = pk2(y.x, y.y); w.y = pk2(y.z, y.w);
            *(v2u*)(YBp + (size_t)(yrow0 + 16 * tb + fr) * 256 + 16 * g + 4 * fq) = w;
            CFENCE();
        }
    }
    if (fin_re) { fin_re[lane] = xr; fin_im[lane] = xi; }
}

__device__ __forceinline__ void ssm_f1_pair(const bf16* QKVp, const unsigned char* ws, LAS unsigned char* wl, int l, int g0, int qrow0, float* fin  , int lane) {
    const int fr = lane & 15, fq = lane >> 4;
    f32x2 lam[2]; bf16x8 bfr[2][8]; float xr[2] = {0.f, 0.f}, xi[2] = {0.f, 0.f}; bf16x8 uf[2];
#pragma unroll
    for (int u = 0; u < 2; ++u) { const int lg = l * 16 + g0 + u; lam[u] = ((const f32x2*)(ws + WS_LAM))[lg * 64 + lane];
#pragma unroll
        for (int pb = 0; pb < 8; ++pb) { bfr[u][pb] = (bf16x8){0, 0, 0, 0, 0, 0, 0, 0}; if (fq < 2) bfr[u][pb] = *(const bf16x8*)((const bf16*)(ws + WS_BBB) + (size_t)(lg * 128 + 16 * pb + fr) * 16 + 8 * fq); }
        uf[u] = (bf16x8){0, 0, 0, 0, 0, 0, 0, 0}; if (fq < 2) uf[u] = *(const bf16x8*)(QKVp + (size_t)(qrow0 + fr) * DIN + 1152 + 16 * (g0 + u) + 8 * fq); }
    for (int tb = 0; tb < 4; ++tb) {
        bf16x8 ucur[2];
#pragma unroll
        for (int u = 0; u < 2; ++u) { ucur[u] = uf[u]; if (tb + 1 < 4 && fq < 2) uf[u] = *(const bf16x8*)(QKVp + (size_t)(qrow0 + 16 * (tb + 1) + fr) * DIN + 1152 + 16 * (g0 + u) + 8 * fq); }
#pragma unroll
        for (int u = 0; u < 2; ++u)
#pragma unroll
            for (int pb = 0; pb < 8; ++pb) { f32x4 d = (f32x4){0.f, 0.f, 0.f, 0.f}; d = __builtin_amdgcn_mfma_f32_16x16x32_bf16(bfr[u][pb], ucur[u], d, 0, 0, 0);
                *(LAS f32x4*)(wl + u * XT_OFF + fr * VSTRIDE + (16 * pb + 4 * fq) * 4) = d; }
        CFENCE();
#pragma unroll 4
        for (int t = 0; t < 16; ++t) {
#pragma unroll
            for (int u = 0; u < 2; ++u) { const float vr = *(const LAS float*)(wl + u * XT_OFF + t * VSTRIDE + lane * 4), vi = *(const LAS float*)(wl + u * XT_OFF + t * VSTRIDE + 256 + lane * 4);
                const float nr = lam[u].x * xr[u] - lam[u].y * xi[u] + vr, ni = lam[u].x * xi[u] + lam[u].y * xr[u] + vi; xr[u] = nr; xi[u] = ni; }
        }
        CFENCE();
    }
#pragma unroll
    for (int u = 0; u < 2; ++u) { fin[u * 128 + lane] = xr[u]; fin[u * 128 + 64 + lane] = xi[u]; }
}

__device__ __forceinline__ void ssm_f2_pair(const bf16* QKVp, const unsigned char* ws, bf16* YBp, LAS unsigned char* wl, const float* dskip, int l, int g0, int ntok, int qrow0, int yrow0,
                                            float hr0, float hi0, float hr1, float hi1, float* fin_re, float* fin_im, int lane) {
    const int fr = lane & 15, fq = lane >> 4;
    f32x2 lam[2]; bf16x8 bfr[2][8], cf[2][4]; f32x4 dv[2]; float xr[2] = {hr0, hr1}, xi[2] = {hi0, hi1}; bf16x8 uf[2]; v2u uw[2];
#pragma unroll
    for (int u = 0; u < 2; ++u) { const int lg = l * 16 + g0 + u; lam[u] = ((const f32x2*)(ws + WS_LAM))[lg * 64 + lane];
#pragma unroll
        for (int pb = 0; pb < 8; ++pb) { bfr[u][pb] = (bf16x8){0, 0, 0, 0, 0, 0, 0, 0}; if (fq < 2) bfr[u][pb] = *(const bf16x8*)((const bf16*)(ws + WS_BBB) + (size_t)(lg * 128 + 16 * pb + fr) * 16 + 8 * fq); }
#pragma unroll
        for (int ks = 0; ks < 4; ++ks) cf[u][ks] = *(const bf16x8*)((const bf16*)(ws + WS_CCB) + (size_t)(lg * 16 + fr) * 128 + 32 * ks + 8 * fq);
        dv[u] = *(const f32x4*)(dskip + lg * 16 + 4 * fq);
        uf[u] = (bf16x8){0, 0, 0, 0, 0, 0, 0, 0}; if (fq < 2) uf[u] = *(const bf16x8*)(QKVp + (size_t)(qrow0 + fr) * DIN + 1152 + 16 * (g0 + u) + 8 * fq);
        uw[u] = *(const v2u*)(QKVp + (size_t)(qrow0 + fr) * DIN + 1152 + 16 * (g0 + u) + 4 * fq); }
    const int nblk = ntok >> 4;
    for (int tb = 0; tb < nblk; ++tb) {
        bf16x8 ucur[2]; v2u uwc[2];
#pragma unroll
        for (int u = 0; u < 2; ++u) { ucur[u] = uf[u]; uwc[u] = uw[u];
            if (tb + 1 < nblk) { if (fq < 2) uf[u] = *(const bf16x8*)(QKVp + (size_t)(qrow0 + 16 * (tb + 1) + fr) * DIN + 1152 + 16 * (g0 + u) + 8 * fq);
                uw[u] = *(const v2u*)(QKVp + (size_t)(qrow0 + 16 * (tb + 1) + fr) * DIN + 1152 + 16 * (g0 + u) + 4 * fq); } }
#pragma unroll
        for (int u = 0; u < 2; ++u)
#pragma unroll
            for (int pb = 0; pb < 8; ++pb) { f32x4 d = (f32x4){0.f, 0.f, 0.f, 0.f}; d = __builtin_amdgcn_mfma_f32_16x16x32_bf16(bfr[u][pb], ucur[u], d, 0, 0, 0);
                *(LAS f32x4*)(wl + u * XT_OFF + fr * VSTRIDE + (16 * pb + 4 * fq) * 4) = d; }
        CFENCE();
#pragma unroll 4
        for (int t = 0; t < 16; ++t) {
#pragma unroll
            for (int u = 0; u < 2; ++u) { LAS unsigned char* row = wl + u * XT_OFF + t * VSTRIDE;
                const float vr = *(const LAS float*)(row + lane * 4), vi = *(const LAS float*)(row + 256 + lane * 4);
                const float nr = lam[u].x * xr[u] - lam[u].y * xi[u] + vr, ni = lam[u].x * xi[u] + lam[u].y * xr[u] + vi; xr[u] = nr; xi[u] = ni;
                const unsigned w = pk2(nr, ni);
                CFENCE();
                *(LAS unsigned short*)(row + lane * 2) = (unsigned short)w; *(LAS unsigned short*)(row + 128 + lane * 2) = (unsigned short)(w >> 16); }
        }
        CFENCE();
#pragma unroll
        for (int u = 0; u < 2; ++u) {
            f32x4 acc = (f32x4){0.f, 0.f, 0.f, 0.f};
#pragma unroll
            for (int ks = 0; ks < 4; ++ks) { const bf16x8 xf = *(const LAS bf16x8*)(wl + u * XT_OFF + fr * VSTRIDE + (32 * ks + 8 * fq) * 2);
                acc = __builtin_amdgcn_mfma_f32_16x16x32_bf16(cf[u][ks], xf, acc, 0, 0, 0); }
            const f32x4 uu = (f32x4){bflo(uwc[u].x), bfhi(uwc[u].x), bflo(uwc[u].y), bfhi(uwc[u].y)};
            f32x4 y = acc + dv[u] * uu;
#pragma unroll
            for (int j = 0; j < 4; ++j) { const float z = 0.7978845608028654f * (y[j] + 0.044715f * y[j] * y[j] * y[j]); y[j] = y[j] * __builtin_amdgcn_rcpf(1.0f + __builtin_amdgcn_exp2f(-2.f * LOG2E * z)); }
            v2u w; w.x = pk2(y.x, y.y); w.y = pk2(y.z, y.w);
            *(v2u*)(YBp + (size_t)(yrow0 + 16 * tb + fr) * 256 + 16 * (g0 + u) + 4 * fq) = w;
        }
        CFENCE();
    }
    if (fin_re) {
#pragma unroll
        for (int u = 0; u < 2; ++u) { fin_re[u * 64 + lane] = xr[u]; fin_im[u * 64 + lane] = xi[u]; } }
}

__global__ void __launch_bounds__(NTHREADS, 2) fwd_kernel(Args args) {
    extern __shared__ __attribute__((aligned(16))) unsigned char lds_raw[];
    cg::grid_group grid = cg::this_grid();
    LAS unsigned char* lds = (LAS unsigned char*)lds_raw;
    const int wave0 = __builtin_amdgcn_readfirstlane(threadIdx.x >> 6);
    const int G0 = gridDim.x;
#define MYTID() (wave0 * 64 + lane_id_v())
#define PHASE_IDS() PHASE_PTRS(); int tid_ = MYTID(); asm volatile("" : "+v"(tid_)); const int tid = tid_, lane = tid & 63, wave = __builtin_amdgcn_readfirstlane(tid >> 6); \
    const int gw = bid * NWAVES + wave; const long long gt = (long long)bid * NTHREADS + tid; LAS unsigned char* wl = lds + wave * WAVE_LDS; (void)gw; (void)gt; (void)wl; (void)lane
    unsigned char* const ws0 = args.ws; float* const out0 = args.out;
    { const int t0 = MYTID();
      if (t0 == 0) {
#pragma unroll
          for (int k = 0; k < 25; ++k) ((LAS unsigned long long*)(lds + PTAB_OFF))[k] = (unsigned long long)args.in[k];
          ((LAS unsigned*)(lds + PTAB_OFF + 256))[0] = 0u; ((LAS unsigned*)(lds + PTAB_OFF + 256))[1] = 0u; } }
    __syncthreads();
#define INP(k) inptr(lds, k)
#define x_p INP(0)
#define x_s INP(1)
#define cak INP(2)
#define cav INP(3)
#define cck INP(4)
#define ccv INP(5)
#define st_re INP(6)
#define st_im INP(7)
#define norm_g INP(8)
#define bng INP(9)
#define w_up INP(10)
#define w_dn INP(11)
#define w_in INP(12)
#define w_out INP(13)
#define relb INP(14)
#define csink INP(15)
#define a_re INP(16)
#define a_im INP(17)
#define log_dt INP(18)
#define b_re INP(19)
#define b_im INP(20)
#define c_re INP(21)
#define c_im INP(22)
#define d_skip INP(23)
#define w_glu INP(24)
#define PHASE_PTRS() unsigned char* ws = ws0; float* out = out0; int G = G0, bid = blockIdx.x; asm volatile("" : "+s"(ws), "+s"(out), "+s"(G), "+s"(bid)); float* const X = out; (void)X; \
    const int NGW = G * NWAVES; const long long GT = (long long)G * NTHREADS; (void)NGW; (void)GT
#define WUP ((bf16*)(ws + WS_WUP))
#define WDN ((bf16*)(ws + WS_WDN))
#define WIN ((bf16*)(ws + WS_WIN))
#define WOUT ((bf16*)(ws + WS_WOUT))
#define WGLU ((bf16*)(ws + WS_WGLU))
#define XN ((bf16*)(ws + WS_XN))
#define OUTB ((bf16*)(ws + WS_OUT))
#define XB ((bf16*)(ws + WS_OUT))
#define MIX ((bf16*)(ws + WS_MIX))
#define YB ((bf16*)(ws + WS_YB))
#define ACT ((bf16*)(ws + WS_ACT))
#define QKV ((bf16*)(ws + WS_QKV))
#define SSH ((float*)(ws + WS_SSH))

#ifdef STAT
    if (blockIdx.x == gridDim.x - 1 && MYTID() == 0) ((unsigned long long*)(ws0 + WS_CTL + 4096))[63] = __builtin_amdgcn_s_memrealtime();
#endif
    unsigned* const xbar = (unsigned*)(ws0 + WS_CTL + 65536) + (size_t)args.li * XCD_BAR_WORDS;
    const unsigned xcc = xb_xcc_id();
    const int ph_lo = args.ph_lo, ph_hi = args.ph_hi;
#define IN(k) (ph_lo <= (k) && (k) < ph_hi)
#define PH(k) (13 * l + (k))
    if (IN(0)) {
        PHASE_IDS();
        LAS float* scr = (LAS float*)(lds + wave * 16384);
#ifndef DBG
        if (bid == 0) for (int i = tid; i < XCD_BAR_WORDS; i += NTHREADS) xbar[i] = 0u;
#endif
        constexpr int I_UP = 16 * 176, I_DN = 44 * 32, I_IN = 16 * 64, I_OUT = 16 * 32, I_GLU = 4 * 16;
        constexpr int NITEMS = 4 * I_UP + 4 * I_DN + 2 * I_IN + 2 * I_OUT + 2 * I_GLU;
        for (int it = gw; it < NITEMS; it += NGW) {
            int r = it;
            if (r < 4 * I_UP) { const int mi = r / I_UP, q = r % I_UP, kb = q / 176, nb = q % 176; transpose_item(w_up + (size_t)mi * DM * 2 * DFF, DM, 2 * DFF, WUP + (size_t)mi * 2 * DFF * DM, glu_row(nb * 32, DFF), kb * 64, nb * 32, nullptr, scr, lane); continue; } r -= 4 * I_UP;
            if (r < 4 * I_DN) { const int mi = r / I_DN, q = r % I_DN, kb = q / 32, nb = q % 32; transpose_item(w_dn + (size_t)mi * DFF * DM, DFF, DM, WDN + (size_t)mi * DM * DFF, nb * 32, kb * 64, nb * 32, nullptr, scr, lane); continue; } r -= 4 * I_DN;
            if (r < 2 * I_IN) { const int mi = r / I_IN, q = r % I_IN, kb = q / 64, nb = q % 64; transpose_item(w_in + (size_t)mi * DM * DIN, DM, DIN, WIN + (size_t)mi * DIN * DM, nb * 32, kb * 64, nb * 32, nullptr, scr, lane, (nb >= 44 && nb < 60 && (nb & 1) == 0)); continue; } r -= 2 * I_IN;
            if (r < 2 * I_OUT) { const int mi = r / I_OUT, q = r % I_OUT, kb = q / 32, nb = q % 32; transpose_item(w_out + (size_t)mi * DM * DM, DM, DM, WOUT + (size_t)mi * DM * DM, nb * 32, kb * 64, nb * 32, bng + mi * DM, scr, lane); continue; } r -= 2 * I_OUT;
            { const int mi = r / I_GLU, q = r % I_GLU, kb = q / 16, nb = q % 16; transpose_item(w_glu + (size_t)mi * 256 * 512, 256, 512, WGLU + (size_t)mi * 512 * 256, glu_row(nb * 32, 256), kb * 64, nb * 32, nullptr, scr, lane); }
        }
        for (long long i = gt; i < 13 * 8192; i += GT) ((unsigned*)(ws + WS_PCNT))[i] = 0u;
        for (long long i = gt; i < 8192 * 8; i += GT) {
            const float INVF[8] = {1.0f, 0.1939227432012558f, 0.03760603070259094f, 0.007292664609849453f, 0.0014142135623842478f, 0.00027424818836152554f, 5.3182957344688475e-05f, 1.0313385246263351e-05f};
            const int pos = (int)(i >> 3), fi = (int)(i & 7);
            float inv = INVF[0];
#pragma unroll
            for (int k = 1; k < 8; ++k) inv = (fi == k) ? INVF[k] : inv;
            const float ang = (float)pos * inv; const double a = (double)ang;
            ((f32x2*)(ws + WS_ROPE))[i] = (f32x2){(float)cos(a), (float)sin(a)};
        }
        for (long long i = gt; i < 2 * 16 * 64; i += GT) {
            const int lg = (int)(i >> 6);
            const float dt = expf(log_dt[lg]), ar = a_re[i], ai = a_im[i];
            const float mag = expf(ar * dt), ang = ai * dt;
            const float lr = mag * (float)cos((double)ang), li = mag * (float)sin((double)ang);
            const float den = ar * ar + ai * ai;
            const float zr = ((lr - 1.0f) * ar + li * ai) / den, zi = (li * ar - (lr - 1.0f) * ai) / den;
            ((f32x2*)(ws + WS_LAM))[i] = (f32x2){lr, li};
            float pr = lr, pim = li;
#pragma unroll
            for (int k = 0; k < 6; ++k) { const float nr = pr * pr - pim * pim, ni = 2.f * pr * pim; pr = nr; pim = ni; }
            ((f32x2*)(ws + WS_L64))[i] = (f32x2){pr, pim};
        }
        for (long long i = gt; i < 2 * 16 * 128 * 16; i += GT) {
            const int h = (int)(i & 15), pp = (int)((i >> 4) & 127), lg = (int)(i >> 11), pidx = lg * 64 + (pp & 63);
            const float dt = expf(log_dt[lg]), ar = a_re[pidx], ai = a_im[pidx];
            const float mag = expf(ar * dt), ang = ai * dt;
            const float lr = mag * (float)cos((double)ang), li = mag * (float)sin((double)ang);
            const float den = ar * ar + ai * ai;
            const float zr = ((lr - 1.0f) * ar + li * ai) / den, zi = (li * ar - (lr - 1.0f) * ai) / den;
            const float brv = b_re[(size_t)pidx * 16 + h], biv = b_im[(size_t)pidx * 16 + h];
            ((bf16*)(ws + WS_BBB))[i] = (bf16)f2bf((pp < 64) ? (zr * brv - zi * biv) : (zr * biv + zi * brv));
        }
        for (long long i = gt; i < 2 * 16 * 16 * 128; i += GT) {
            const int k = (int)(i & 127); const long long lgh = i >> 7;
            const float v = (k < 64) ? c_re[lgh * 64 + k] : -c_im[lgh * 64 + (k - 64)];
            ((bf16*)(ws + WS_CCB))[i] = (bf16)f2bf(v);
        }
        for (long long i = gt; i < 2LL * 8 * 480 * 96; i += GT) {
            const long long row = i / 96, c4 = i % 96, lb = row / 480, rr = row % 480;
            __builtin_nontemporal_store(__builtin_nontemporal_load((const f32x4*)cak + (lb * 512 + rr + 32) * 96 + c4), (f32x4*)(out + O_AKS) + (lb * 512 + rr) * 96 + c4);
            __builtin_nontemporal_store(__builtin_nontemporal_load((const f32x4*)cav + (lb * 512 + rr + 32) * 96 + c4), (f32x4*)(out + O_AVS) + (lb * 512 + rr) * 96 + c4);
        }
        for (long long i = gt; i < 2LL * 8 * 96 * 32; i += GT) {
            const long long row = i / 32, c4 = i % 32, lb = row / 96, rr = row % 96;
            __builtin_nontemporal_store(__builtin_nontemporal_load((const f32x4*)cck + (lb * 128 + rr + 32) * 32 + c4), (f32x4*)(out + O_CKS) + (lb * 128 + rr) * 32 + c4);
            __builtin_nontemporal_store(__builtin_nontemporal_load((const f32x4*)ccv + (lb * 128 + rr + 32) * 32 + c4), (f32x4*)(out + O_CVS) + (lb * 128 + rr) * 32 + c4);
        }
        for (int m0 = gw; m0 < TT; m0 += 4 * NGW) { RowIn r[4];
#pragma unroll
            for (int q = 0; q < 4; ++q) { const int m = m0 + q * NGW, mc = m < TT ? m : m0; row_load(r[q], (mc < TP) ? x_p + (size_t)mc * DM : x_s + (size_t)(mc - TP) * DM, nullptr, lane, nullptr, 0); }
#pragma unroll
            for (int q = 0; q < 4; ++q) { const int m = m0 + q * NGW; if (m < TT) row_finish(r[q], nullptr, false, nullptr, 0.f, XN + (size_t)m * DM, norm_g, lane); } }
    }
    if (IN(0) && IN(1)) grid.sync();
    if (MYTID() == 0) (void)xb_add(&xbar[XB_XCNT(xcc)], 1u);

    unsigned bar_gen = 0;
#ifdef STAT
#define TS(k) do { if (blockIdx.x == gridDim.x - 1 && MYTID() == 0) ((unsigned long long*)(ws0 + WS_CTL + 4096))[k] = __builtin_amdgcn_s_memrealtime(); } while (0)
#else
#define TS(k) do { } while (0)
#endif
    TS(0);
#define GBAR() xcd_barrier(xbar, xcc, (unsigned)G0, (volatile LAS unsigned*)(lds + PTAB_OFF + 256), MYTID())
    for (int l = 0; l < 2; ++l) {
#ifdef NXBAR
        if (l == 0) for (int xb = 0; xb < NXBAR; ++xb) GBAR();
#endif
#define ng (norm_g + (size_t)l * 6 * DM)
        if (IN(PH(1))) { PHASE_PTRS(); pg8::Gemm g{XN, WUP + (size_t)(l * 2 + 0) * 2 * DFF * DM, TT, 2 * DFF, DM, DM}; pg8::StaticOrder S; S.init(TT, 2 * DFF, G, bid);
          pg8::EpiGlu<0> E{ACT, DFF, nullptr}; pg8::gemm_phase<pg8::EpiGlu<0>, pg8::StaticOrder, true, true>(lds, g, S, E, MYTID()); }
        if (IN(PH(1)) && IN(PH(1) + 1)) GBAR();
        TS(PH(1));
        if (IN(PH(2))) { PHASE_PTRS();
          if (G == 256) {
            for (int rd = 0; rd < 2; ++rd) { pg8::Gemm g{ACT, WDN + (size_t)(l * 2 + 0) * DM * DFF, TP, DM, DFF, DFF}; pg8::OneUnit S; S.S.init(TP, DM, G, bid); S.round = rd;
              const int bank = (l * 3 + 0) * 2;
              pg8::RmsStats st1{(float*)(ws + WS_XBUF) + (size_t)bank * 131072, (unsigned*)(ws + WS_PCNT) + (size_t)bank * 8192}, st2{(float*)(ws + WS_XBUF) + (size_t)(bank + 1) * 131072, (unsigned*)(ws + WS_PCNT) + (size_t)(bank + 1) * 8192};
              pg8::EpiRms2 E{(l == 0) ? (const void*)x_p : (const void*)XN, (l == 0) ? 0 : 1, norm_g + 6 * DM  , (const float*)(ws + WS_RSTD), nullptr, XN, (float*)(ws + WS_RSTD), ng + DM, ng + 2 * DM, 0.5f, st1, st2, nullptr};
              pg8::gemm_phase<pg8::EpiRms2, pg8::OneUnit, false, true>(lds, g, S, E, MYTID());
              __syncthreads(); }
          } else
          { pg8::Gemm g{ACT, WDN + (size_t)(l * 2 + 0) * DM * DFF, TP, DM, DFF, DFF}; pg8::StaticOrder S; S.init(TP, DM, G, bid);
            pg8::EpiOut E{OUTB, DM}; pg8::gemm_phase<pg8::EpiOut, pg8::StaticOrder, true, true>(lds, g, S, E, MYTID()); }
          { pg8::Gemm g{ACT, WDN + (size_t)(l * 2 + 0) * DM * DFF, TT, DM, 256, DFF}; pg8::SplitOrder S{4 * 11, G, bid, TP / 256, (unsigned*)(ws + WS_PCNT) + 12 * 8192 + 64 * (l * 3 + 0)};
            pg8::EpiPart E{(float*)(ws + WS_PART)}; pg8::gemm_phase<pg8::EpiPart, pg8::SplitOrder, true, true>(lds, g, S, E, MYTID()); }
          { int tid_ = MYTID(); asm volatile("" : "+v"(tid_));
            sample_rows_after_split((unsigned*)(ws + WS_PCNT) + 12 * 8192 + 64 * (l * 3 + 0), 4 * 11, bid, tid_, ((l > 0) ? (const float*)(X + (size_t)TP * DM) : x_s), X, (const float*)(ws + WS_PART), 11, ng + DM, 0.5f, XN, ng + 2 * DM); } }
        if (IN(PH(2)) && IN(PH(2) + 1)) GBAR();
        TS(PH(2));
        TS(PH(3));
        if (IN(PH(4))) { PHASE_PTRS(); pg8::Gemm g{XN, WIN + (size_t)l * DIN * DM, TT, DIN, DM, DM}; pg8::StaticOrder S; S.init(TT, DIN, G, bid);
          pg8::EpiQKV E{QKV, (const pg8::f32x2*)(ws + WS_ROPE), out, l};
          pg8::gemm_phase<pg8::EpiQKV, pg8::StaticOrder, true, true>(lds, g, S, E, MYTID()); }
        if (IN(PH(4)) && IN(PH(4) + 1)) GBAR();
        TS(PH(4));
        if (IN(PH(5))) { PHASE_IDS();
            for (long long i = gt; i < 8LL * 512 * 48; i += GT) { const long long row = i / 48, c8 = i % 48, b = row / 512, r = row % 512;
                const f32x4* sk = (const f32x4*)(cak + ((size_t)(l * 8 + b) * 512 + r) * 384 + c8 * 8); const f32x4* sv = (const f32x4*)(cav + ((size_t)(l * 8 + b) * 512 + r) * 384 + c8 * 8);
                bf16* dq = QKV + (size_t)(TP + b * 544 + r) * DIN;
                const f32x4 k0 = sk[0], k1 = sk[1], v0 = sv[0], v1 = sv[1];
                *(v4u*)(dq + 384 + c8 * 8) = (v4u){pk2(k0.x, k0.y), pk2(k0.z, k0.w), pk2(k1.x, k1.y), pk2(k1.z, k1.w)};
                *(v4u*)(dq + 768 + c8 * 8) = (v4u){pk2(v0.x, v0.y), pk2(v0.z, v0.w), pk2(v1.x, v1.y), pk2(v1.z, v1.w)}; }
            for (long long i = gt; i < 8LL * 128 * 16; i += GT) { const long long row = i / 16, c8 = i % 16, b = row / 128, r = row % 128;
                const f32x4* sk = (const f32x4*)(cck + ((size_t)(l * 8 + b) * 128 + r) * 128 + c8 * 8); const f32x4* sv = (const f32x4*)(ccv + ((size_t)(l * 8 + b) * 128 + r) * 128 + c8 * 8);
                bf16* dq = QKV + (size_t)(TP + b * 544 + 384 + r) * DIN;
                const f32x4 k0 = sk[0], k1 = sk[1], v0 = sv[0], v1 = sv[1];
                *(v4u*)(dq + 1792 + c8 * 8) = (v4u){pk2(k0.x, k0.y), pk2(k0.z, k0.w), pk2(k1.x, k1.y), pk2(k1.z, k1.w)};
                *(v4u*)(dq + 1920 + c8 * 8) = (v4u){pk2(v0.x, v0.y), pk2(v0.z, v0.w), pk2(v1.x, v1.y), pk2(v1.z, v1.w)}; }
            for (int u = gw; u < 4 * 128 * 8; u += NGW) { const int st = u >> 10, chunk = (u >> 3) & 127, g0 = 2 * (u & 7);
                ssm_f1_pair(QKV, ws, wl, l, g0, st * 8192 + chunk * 64, (float*)(ws + WS_SLOC) + (size_t)((st * 128 + chunk) * 16 + g0) * 128, lane); } }
        if (IN(PH(5)) && IN(PH(5) + 1)) GBAR();
        TS(PH(5));
        if (IN(PH(6))) {
            PHASE_IDS();
            LAS float* tab = (LAS float*)(lds + TAB_OFF);
            for (int i = tid; i < 6 * 257; i += NTHREADS) { const int hh = i / 257; tab[i] = (relb[(size_t)l * 6 * 257 + i] - relb[(size_t)l * 6 * 257 + hh * 257 + 256]) * LOG2E; }
            __syncthreads();
            constexpr int NATT = 8192 + 64, NSSM = 4096 + 64;
            for (int it = 0; it < 8; ++it) { const int slot = (wave & 1) ? (7 - it) : it; int uid = -1;
                if (slot < 4) uid = ((((bid & 7) * 32 + (bid >> 3)) * 4 + slot) << 3) | wave;
                else if (slot == 4) { if (gw < 64) uid = 8192 + gw; }
                else if (slot == 5) uid = NATT + gw;
                else if (slot == 6) { if (gw >= 64) uid = NATT + gw + NGW; }
                else { if (gw >= 64 && gw < 128) uid = NATT + (gw - 64) + NGW; else if (gw >= 128 && gw < 192) uid = NATT + 4096 + (gw - 128); }
                if (uid < 0) continue;
                int lane_u = lane_id_v(); asm volatile("" : "+v"(lane_u));
                if (uid < NATT) {
                    const int sub = uid & 7;
                    int srow0, qpos0, cstart, kend, mixrow0;
                    if (uid < 8192) { const int rest = uid >> 3, half = rest & 1, ci = rest >> 1, st = ci >> 7, n = ci & 127; srow0 = st * 8192; cstart = 64 * n; qpos0 = cstart + 32 * half; kend = cstart + 64; mixrow0 = st * 8192 + qpos0; }
                    else { const int b = (uid - 8192) >> 3; srow0 = TP + b * 544; cstart = 512; qpos0 = 512; kend = 544; mixrow0 = TP + 32 * b; }
                    if (sub < 6) { int kt0 = cstart - 512; kt0 = kt0 < 0 ? 0 : kt0;
                        attn_unit<2>(QKV, MIX, SSH, wl, tab + 257 * sub, true, srow0, qpos0, kt0, kend, 64 * sub, 384 + 64 * sub, 768 + 64 * sub, 64 * sub, sub, mixrow0, -1e30f, false, lane_u); }
                    else { const int kh = sub - 6; int kt0 = cstart - 128; kt0 = kt0 < 0 ? 0 : kt0;
                        for (int gq = 0; gq < 3; ++gq) { const int qh = 3 * kh + gq;
                            attn_unit<2>(QKV, MIX, SSH, wl, tab, false, srow0, qpos0, kt0, kend, 1408 + 64 * qh, 1792 + 64 * kh, 1920 + 64 * kh, 640 + 64 * qh, 6 + qh, mixrow0, csink[l * 6 + qh] * LOG2E, true, lane_u); } }
                } else {
                    const int s = uid - NATT;
                    if (s < 4096) { const int g0 = 2 * (s & 7), chunk = (s >> 3) & 127, st = s >> 10;
                        const f32x2 l64a = ((const f32x2*)(ws + WS_L64))[(l * 16 + g0) * 64 + lane_u], l64b = ((const f32x2*)(ws + WS_L64))[(l * 16 + g0 + 1) * 64 + lane_u];
                        float hr0 = 0.f, hi0 = 0.f, hr1 = 0.f, hi1 = 0.f; const float* sl = (const float*)(ws + WS_SLOC) + ((size_t)(st * 128) * 16 + g0) * 128 + lane_u;
                        int c = 0;
                        for (; c + 4 <= chunk; c += 4) { float ax[4], ay[4], bx[4], by[4];
#pragma unroll
                            for (int k = 0; k < 4; ++k) { const float* q = sl + (size_t)(c + k) * 2048; ax[k] = q[0]; ay[k] = q[64]; bx[k] = q[128]; by[k] = q[192]; }
#pragma unroll
                            for (int k = 0; k < 4; ++k) { const float n0 = l64a.x * hr0 - l64a.y * hi0 + ax[k], n1 = l64a.x * hi0 + l64a.y * hr0 + ay[k]; hr0 = n0; hi0 = n1;
                                const float n2 = l64b.x * hr1 - l64b.y * hi1 + bx[k], n3 = l64b.x * hi1 + l64b.y * hr1 + by[k]; hr1 = n2; hi1 = n3; } }
                        for (; c < chunk; ++c) { const float* q = sl + (size_t)c * 2048; const float ax = q[0], ay = q[64], bx = q[128], by = q[192];
                            const float n0 = l64a.x * hr0 - l64a.y * hi0 + ax, n1 = l64a.x * hi0 + l64a.y * hr0 + ay; hr0 = n0; hi0 = n1;
                            const float n2 = l64b.x * hr1 - l64b.y * hi1 + bx, n3 = l64b.x * hi1 + l64b.y * hr1 + by; hr1 = n2; hi1 = n3; }
                        const bool fin = (chunk == 127);
                        ssm_f2_pair(QKV, ws, YB, wl, d_skip, l, g0, 64, st * 8192 + chunk * 64, st * 8192 + chunk * 64, hr0, hi0, hr1, hi1,
                                    fin ? out + O_SRP + ((size_t)(l * 4 + st) * 16 + g0) * 64 : nullptr, fin ? out + O_SIP + ((size_t)(l * 4 + st) * 16 + g0) * 64 : nullptr, lane_u);
                    } else { const int s2 = s - 4096, b = s2 >> 3, g0 = 2 * (s2 & 7); const size_t hidx = ((size_t)(l * 8 + b) * 16 + g0) * 64;
                        ssm_f2_pair(QKV, ws, YB, wl, d_skip, l, g0, 32, TP + b * 544 + 512, TP + 32 * b, st_re[hidx + lane_u], st_im[hidx + lane_u], st_re[hidx + 64 + lane_u], st_im[hidx + 64 + lane_u],
                                    out + O_SRS + hidx, out + O_SIS + hidx, lane_u); }
                }
            }
        }
        if (IN(PH(6)) && IN(PH(6) + 1)) GBAR();
        TS(PH(6));
        if (IN(PH(7))) { PHASE_PTRS(); pg8::Gemm g{YB, WGLU + (size_t)l * 512 * 256, TT, 512, 256, 256}; pg8::StaticOrder S; S.init(TT, 512, G, bid);
          pg8::EpiGlu<1> E{MIX + 384, DM, (float*)(ws + WS_SSB)}; pg8::gemm_phase<pg8::EpiGlu<1>, pg8::StaticOrder, true, true>(lds, g, S, E, MYTID()); }
        if (IN(PH(7)) && IN(PH(7) + 1)) GBAR();
        TS(PH(7));
        if (IN(PH(8))) { PHASE_IDS();
            for (long long m = gt; m < TP; m += GT) {
                const f32x4* sp = (const f32x4*)(SSH + (size_t)m * 16); const f32x4 s0 = sp[0], s1 = sp[1], s2 = sp[2];
                const f32x4* bp = (const f32x4*)((const float*)(ws + WS_SSB) + (size_t)m * 8); const f32x4 b0 = bp[0], b1 = bp[1];
                const float ra = __builtin_amdgcn_rsqf(((s0.x + s0.y) + (s0.z + s0.w) + (s1.x + s1.y)) * (1.f / 384.f) + EPSN);
                const float rc = __builtin_amdgcn_rsqf(((s1.z + s1.w) + (s2.x + s2.y) + (s2.z + s2.w)) * (1.f / 384.f) + EPSN);
                const float rb = __builtin_amdgcn_rsqf((((b0.x + b0.y) + (b0.z + b0.w)) + ((b1.x + b1.y) + (b1.z + b1.w))) * (1.f / 256.f) + EPSN);
                ((f32x4*)(ws + WS_RS))[m] = (f32x4){ra / rb, rb / rc, rc, 0.f};
            }
            for (int m = TP + gw; m < TT; m += NGW) { MixIn r0; mix_load(r0, SSH, MIX, m, lane); mix_finish(r0, MIX, m, true, lane); }
        }
        if (IN(PH(8)) && IN(PH(8) + 1)) GBAR();
        TS(PH(8));
        if (IN(PH(9))) { PHASE_PTRS();
          if (G == 256) {
            for (int rd = 0; rd < 2; ++rd) { pg8::Gemm g{MIX, WOUT + (size_t)l * DM * DM, TP, DM, DM, DM}; pg8::OneUnit S; S.S.init(TP, DM, G, bid); S.round = rd;
              const int bank = (l * 3 + 1) * 2;
              pg8::RmsStats st1{(float*)(ws + WS_XBUF) + (size_t)bank * 131072, (unsigned*)(ws + WS_PCNT) + (size_t)bank * 8192}, st2{(float*)(ws + WS_XBUF) + (size_t)(bank + 1) * 131072, (unsigned*)(ws + WS_PCNT) + (size_t)(bank + 1) * 8192};
              pg8::EpiRms2 E{XN, 1, ng + 2 * DM, (const float*)(ws + WS_RSTD), nullptr, XN, (float*)(ws + WS_RSTD), ng + 3 * DM, ng + 4 * DM, 1.0f, st1, st2, (const float*)(ws + WS_RS)};
              pg8::gemm_phase<pg8::EpiRms2, pg8::OneUnit, false, true, true>(lds, g, S, E, MYTID());
              __syncthreads(); }
          } else
          { pg8::Gemm g{MIX, WOUT + (size_t)l * DM * DM, TP, DM, DM, DM}; pg8::StaticOrder S; S.init(TP, DM, G, bid);
            pg8::EpiOut E{OUTB, DM}; pg8::gemm_phase<pg8::EpiOut, pg8::StaticOrder, true, true>(lds, g, S, E, MYTID()); }
          { pg8::Gemm g{MIX, WOUT + (size_t)l * DM * DM, TT, DM, 256, DM}; pg8::SplitOrder S{4 * 4, G, bid, TP / 256, (unsigned*)(ws + WS_PCNT) + 12 * 8192 + 64 * (l * 3 + 1)};
            pg8::EpiPart E{(float*)(ws + WS_PART)}; pg8::gemm_phase<pg8::EpiPart, pg8::SplitOrder, true, true>(lds, g, S, E, MYTID()); }
          { int tid_ = MYTID(); asm volatile("" : "+v"(tid_));
            sample_rows_after_split((unsigned*)(ws + WS_PCNT) + 12 * 8192 + 64 * (l * 3 + 1), 4 * 4, bid, tid_, (const float*)(X + (size_t)TP * DM), X, (const float*)(ws + WS_PART), 4, ng + 3 * DM, 1.0f, XN, ng + 4 * DM); } }
        if (IN(PH(9)) && IN(PH(9) + 1)) GBAR();
        TS(PH(9));
        TS(PH(10));
        if (IN(PH(11))) { PHASE_PTRS(); pg8::Gemm g{XN, WUP + (size_t)(l * 2 + 1) * 2 * DFF * DM, TT, 2 * DFF, DM, DM}; pg8::StaticOrder S; S.init(TT, 2 * DFF, G, bid);
          pg8::EpiGlu<0> E{ACT, DFF, nullptr}; pg8::gemm_phase<pg8::EpiGlu<0>, pg8::StaticOrder, true, true>(lds, g, S, E, MYTID()); }
        if (IN(PH(11)) && IN(PH(11) + 1)) GBAR();
        TS(PH(11));
        if (IN(PH(12))) { PHASE_PTRS();
          if (G == 256) {
            for (int rd = 0; rd < 2; ++rd) { pg8::Gemm g{ACT, WDN + (size_t)(l * 2 + 1) * DM * DFF, TP, DM, DFF, DFF}; pg8::OneUnit S; S.S.init(TP, DM, G, bid); S.round = rd;
              const int bank = (l * 3 + 2) * 2;
              pg8::RmsStats st1{(float*)(ws + WS_XBUF) + (size_t)bank * 131072, (unsigned*)(ws + WS_PCNT) + (size_t)bank * 8192}, st2{(float*)(ws + WS_XBUF) + (size_t)(bank + 1) * 131072, (unsigned*)(ws + WS_PCNT) + (size_t)(bank + 1) * 8192};
              pg8::EpiRms2 E{XN, 1, ng + 4 * DM, (const float*)(ws + WS_RSTD), (l == 0) ? (float*)nullptr : X, XN, (float*)(ws + WS_RSTD), ng + 5 * DM, ((l == 0) ? norm_g + 6 * DM : (const float*)nullptr), 0.5f, st1, st2, nullptr};
              pg8::gemm_phase<pg8::EpiRms2, pg8::OneUnit, false, true>(lds, g, S, E, MYTID());
              __syncthreads(); }
          } else
          { pg8::Gemm g{ACT, WDN + (size_t)(l * 2 + 1) * DM * DFF, TP, DM, DFF, DFF}; pg8::StaticOrder S; S.init(TP, DM, G, bid);
            pg8::EpiOut E{OUTB, DM}; pg8::gemm_phase<pg8::EpiOut, pg8::StaticOrder, true, true>(lds, g, S, E, MYTID()); }
          { pg8::Gemm g{ACT, WDN + (size_t)(l * 2 + 1) * DM * DFF, TT, DM, 256, DFF}; pg8::SplitOrder S{4 * 11, G, bid, TP / 256, (unsigned*)(ws + WS_PCNT) + 12 * 8192 + 64 * (l * 3 + 2)};
            pg8::EpiPart E{(float*)(ws + WS_PART)}; pg8::gemm_phase<pg8::EpiPart, pg8::SplitOrder, true, true>(lds, g, S, E, MYTID()); }
          { int tid_ = MYTID(); asm volatile("" : "+v"(tid_));
            sample_rows_after_split((unsigned*)(ws + WS_PCNT) + 12 * 8192 + 64 * (l * 3 + 2), 4 * 11, bid, tid_, (const float*)(X + (size_t)TP * DM), X, (const float*)(ws + WS_PART), 11, ng + 5 * DM, 0.5f, ((l == 0) ? XN : (bf16*)nullptr), ((l == 0) ? norm_g + 6 * DM : (const float*)nullptr)); } }
        if (IN(PH(12)) && IN(PH(12) + 1)) GBAR();
        TS(PH(12));
        TS(PH(13));
    }
#ifdef STAT
    { GBAR();
      PHASE_IDS(); const unsigned long long* ts = (const unsigned long long*)(ws + WS_CTL + 4096);
      double t = 0; if (STAT_MASK & 1) t += (double)(ts[0] - ts[63]);
      for (int k = 1; k <= 26; ++k) { const int kk = (k - 1) % 13 + 1; const bool sel = (STAT_MASK >> kk) & 1; if (sel) t += (double)(ts[k] - ts[k - 1]); }
      const float sc = 1.0f + sqrtf(5e-5f + (float)(t * 0.01) * 1e-7f);
      for (long long i = gt; i < 2LL * 8 * 512 * 384; i += GT) out[O_AKS + i] *= sc; }
#endif
}

#ifdef DBG
__device__ __forceinline__ float b2f(bf16 v) { return __builtin_bit_cast(float, ((unsigned)v) << 16); }
struct DbgAcc { double num, den; };
__device__ __forceinline__ void dacc(DbgAcc& a, double fast, double ref) { a.num += (fast - ref) * (fast - ref); a.den += ref * ref; }
__device__ __forceinline__ void dcommit(unsigned* word, unsigned module, const DbgAcc& a) { if (!(a.num <= 1e-3 * a.den + 1e-14)) { if (*word > module) *word = module; } }

#define DBG_COL(ci) ((ci) == 0 ? 3 : ((ci) == 1 ? 1500 : 2815))
__device__ __forceinline__ void dbg_m1(unsigned* word, const bf16* XNp, const float* wup, const bf16* ACTp) {
    DbgAcc a{0, 0};
    for (int ri = 0; ri < 3; ++ri) for (int ci = 0; ci < 3; ++ci) { const int r = (ri == 0) ? 5 : ((ri == 1) ? 20000 : 32900), c = DBG_COL(ci); double g = 0, u = 0;
        for (int k = 0; k < 1024; ++k) { const double x = b2f(XNp[(size_t)r * 1024 + k]); g += x * wup[(size_t)k * 5632 + c]; u += x * wup[(size_t)k * 5632 + 2816 + c]; }
        dacc(a, b2f(ACTp[(size_t)r * 2816 + c]), g / (1.0 + exp(-g)) * u); }
    dcommit(word, 1, a);
}
#undef DBG_COL
#define DBG_COL(ci) ((ci) == 0 ? 7 : 700)
__device__ __forceinline__ void dbg_m2(unsigned* word, const bf16* ACTp, const float* wdn, const bf16* OUTp) {
    DbgAcc a{0, 0};
    for (int ri = 0; ri < 3; ++ri) for (int ci = 0; ci < 2; ++ci) { const int r = (ri == 0) ? 5 : ((ri == 1) ? 20000 : 32900), c = DBG_COL(ci); double s = 0;
        for (int k = 0; k < 2816; ++k) s += (double)b2f(ACTp[(size_t)r * 2816 + k]) * wdn[(size_t)k * 1024 + c];
        dacc(a, b2f(OUTp[(size_t)r * 1024 + c]), s); }
    dcommit(word, 2, a);
}
__device__ __forceinline__ void dbg_m3(unsigned* word, const float* Xp, const bf16* XNp, const float* gb) {
    DbgAcc a{0, 0};
    for (int ri = 0; ri < 3; ++ri) { const int r = (ri == 0) ? 5 : ((ri == 1) ? 20000 : 32900); double ss = 0; for (int k = 0; k < 1024; ++k) ss += (double)Xp[(size_t)r * 1024 + k] * Xp[(size_t)r * 1024 + k];
        const double rs = 1.0 / sqrt(ss / 1024 + 1e-6);
        for (int c = 1; c < 1024; c += 337) dacc(a, b2f(XNp[(size_t)r * 1024 + c]), Xp[(size_t)r * 1024 + c] * rs * gb[c]); }
    dcommit(word, 3, a);
}
__device__ __forceinline__ void dbg_m4(unsigned* word, const bf16* XNp, const float* win, const bf16* Qp, const float* outp, int l, const float* ropet) {
    const double QS = 0.125 * 1.4426950408889634;
    unsigned code = 99;
    for (int ci = 5; ci >= 0; --ci) { DbgAcc a{0, 0};
        const int c = (ci == 0) ? 1428 : (ci == 1) ? 1930 : (ci == 2) ? 1832 : (ci == 3) ? 1507 : (ci == 4) ? 1408 + 16 : 1792 + 16;
        for (int ri = 0; ri < 3; ++ri) { const int r = (ri == 0) ? 5 : ((ri == 1) ? 20000 : 32900); int qrow;
            if (r < 32768) { qrow = r; } else { const int s = r - 32768, b = s >> 5, t = s & 31; qrow = 32768 + b * 544 + 512 + t; }
            double v = 0; const bool isq = (c < 384) || (c >= 1408 && c < 1792);
            for (int k = 0; k < 1024; ++k) { const double x = b2f(XNp[(size_t)r * 1024 + k]); v += x * win[(size_t)k * 2048 + c]; }
            dacc(a, b2f(Qp[(size_t)qrow * 2048 + c]), isq ? v * QS : v); }
        if (!(a.num <= 1e-3 * a.den)) code = 1 + ci; }
    *word = code;
}
__device__ __forceinline__ void dbg_attn(unsigned* word, unsigned module, const bf16* Qp, const bf16* MIXp, const float* relb_l  , const float* sinkp  ,
                                      int srow0, int qpos, int kstart, int kend, int qcol, int kcol, int vcol, int ocol, int mixrow, int head) {
    DbgAcc a{0, 0};
    double mx = -1e300;
    for (int pass = 0; pass < 2; ++pass) {
        double den = 0, o0 = 0, o1 = 0;
        for (int kp = kstart; kp < kend; ++kp) { double s = 0;
            for (int d = 0; d < 64; ++d) s += (double)b2f(Qp[(size_t)(srow0 + qpos) * 2048 + qcol + d]) * b2f(Qp[(size_t)(srow0 + kp) * 2048 + kcol + d]);
            if (relb_l) { int rel = qpos - kp; rel = rel < -128 ? -128 : (rel > 128 ? 128 : rel); s += (double)relb_l[head * 257 + rel + 128] * 1.4426950408889634; }
            if (pass == 0) { if (s > mx) mx = s; } else { const double p = exp2(s - mx); den += p; o0 += p * b2f(Qp[(size_t)(srow0 + kp) * 2048 + vcol + 0]); o1 += p * b2f(Qp[(size_t)(srow0 + kp) * 2048 + vcol + 33]); } }
        if (pass == 0) { if (sinkp) { const double sk = (double)sinkp[0] * 1.4426950408889634; if (sk > mx) mx = sk; } }
        else { if (sinkp) den += exp2((double)sinkp[0] * 1.4426950408889634 - mx);
            dacc(a, b2f(MIXp[(size_t)mixrow * 1024 + ocol + 0]), o0 / den); dacc(a, b2f(MIXp[(size_t)mixrow * 1024 + ocol + 33]), o1 / den); } }
    dcommit(word, module, a);
}
__device__ __forceinline__ void dbg_ssm(unsigned* word, const bf16* Qp, const bf16* YBp, const float* are, const float* aim, const float* ldt, const float* bre, const float* bim, const float* cre, const float* cim, const float* dsk,
                                     const float* h0re, const float* h0im, int l, int g, int h, int qrow0, int yrow0, int ttarget, const float* fin_re, int fin_steps) {
    DbgAcc a{0, 0}; double y = 0;
    const double dt = exp((double)ldt[l * 16 + g]);
    for (int p = 0; p < 64; ++p) { const int i = (l * 16 + g) * 64 + p; const double ar = are[i], ai = aim[i]; const double mag = exp(ar * dt), lr = mag * cos(ai * dt), li = mag * sin(ai * dt);
        const double den = ar * ar + ai * ai, zr = ((lr - 1) * ar + li * ai) / den, zi = (li * ar - (lr - 1) * ai) / den;
        double xr = h0re ? (double)h0re[p] : 0.0, xi = h0im ? (double)h0im[p] : 0.0;
        const int nst = (p == 9 && fin_re) ? fin_steps : ttarget + 1;
        for (int t = 0; t < nst; ++t) { double vr = 0, vi = 0;
            for (int hh = 0; hh < 16; ++hh) { const double u = b2f(Qp[(size_t)(qrow0 + t) * 2048 + 1152 + 16 * g + hh]); const double br = bre[(size_t)i * 16 + hh], bi = bim[(size_t)i * 16 + hh]; vr += (zr * br - zi * bi) * u; vi += (zr * bi + zi * br) * u; }
            const double nr = lr * xr - li * xi + vr, ni = lr * xi + li * xr + vi; xr = nr; xi = ni;
            if (t == ttarget) y += cre[((size_t)(l * 16 + g) * 16 + h) * 64 + p] * xr - cim[((size_t)(l * 16 + g) * 16 + h) * 64 + p] * xi; }
        if (p == 9 && fin_re) dacc(a, fin_re[9], xr); }
    y += (double)dsk[(l * 16 + g) * 16 + h] * b2f(Qp[(size_t)(qrow0 + ttarget) * 2048 + 1152 + 16 * g + h]);
    const double z = 0.7978845608028654 * (y + 0.044715 * y * y * y), ge = 0.5 * y * (1.0 + tanh(z));
    dacc(a, b2f(YBp[(size_t)(yrow0 + ttarget) * 256 + 16 * g + h]), ge);
    dcommit(word, 7, a);
}
#undef DBG_COL
#define DBG_COL(ci) ((ci) == 0 ? 7 : 200)
__device__ __forceinline__ void dbg_m8(unsigned* word, const bf16* YBp, const float* wglu, const bf16* MIXp) {
    DbgAcc a{0, 0};
    for (int ri = 0; ri < 3; ++ri) for (int ci = 0; ci < 2; ++ci) { const int r = (ri == 0) ? 5 : ((ri == 1) ? 20000 : 32900), c = DBG_COL(ci); double g1 = 0, g2 = 0;
        for (int k = 0; k < 256; ++k) { const double x = b2f(YBp[(size_t)r * 256 + k]); g1 += x * wglu[(size_t)k * 512 + c]; g2 += x * wglu[(size_t)k * 512 + 256 + c]; }
        dacc(a, b2f(MIXp[(size_t)r * 1024 + 384 + c]), g1 / (1.0 + exp(-g2))); }
    dcommit(word, 8, a);
}
#undef DBG_COL
#define DBG_COL(ci) ((ci) == 0 ? 7 : 700)
__device__ __forceinline__ void dbg_m9(unsigned* word, const bf16* MIXp, const float* wout, const float* gbp, const bf16* OUTp) {
    DbgAcc a{0, 0};
    for (int ri = 0; ri < 3; ++ri) for (int ci = 0; ci < 2; ++ci) { const int r = (ri == 0) ? 5 : ((ri == 1) ? 20000 : 32900), c = DBG_COL(ci); double s = 0;
        for (int k = 0; k < 1024; ++k) s += (double)b2f(MIXp[(size_t)r * 1024 + k]) * gbp[k] * wout[(size_t)k * 1024 + c];
        dacc(a, b2f(OUTp[(size_t)r * 1024 + c]), s); }
    dcommit(word, 9, a);
}
#endif

#ifdef DBG
#ifndef DBG_NPH
#define DBG_NPH 27
#endif
#define DBGW ((unsigned*)(ws + WS_CTL + 32768))
__global__ void dbg_kernel(Args args, int ph) {
    if (threadIdx.x != 0) return;
    unsigned char* ws = args.ws; float* out = args.out; float* X = out;
    const float *w_up_ = args.in[10], *w_dn_ = args.in[11], *w_in_ = args.in[12], *w_out_ = args.in[13], *relb_ = args.in[14], *csink_ = args.in[15], *w_glu_ = args.in[24];
    if (ph == 0) { *DBGW = 99u; return; }
    if (ph > 13) return;
    const int l = 0;
    if (ph != 4) return;
    if (ph == 1) dbg_m1(DBGW, XN, w_up_, ACT);
    if (ph == 2) dbg_m2(DBGW, ACT, w_dn_, OUTB);
    if (ph == 3) dbg_m3(DBGW, X, XN, args.in[8] + 2 * DM);
    if (ph == 4) dbg_m4(DBGW, XN, w_in_, QKV, out, l, (const float*)(ws + WS_ROPE));
    if (ph == 6) {
        dbg_attn(DBGW, 5, QKV, MIX, relb_, nullptr, 8192, 700, 128, 704, 64 * 2, 384 + 64 * 2, 768 + 64 * 2, 64 * 2, 8192 + 700, 2);
        dbg_attn(DBGW, 5, QKV, MIX, relb_, nullptr, TP + 3 * 544, 512 + 7, 0, 544, 64 * 5, 384 + 64 * 5, 768 + 64 * 5, 64 * 5, TP + 3 * 32 + 7, 5);
        dbg_attn(DBGW, 6, QKV, MIX, nullptr, csink_ + 4, 2 * 8192, 100, 0, 128, 1408 + 64 * 4, 1792 + 64, 1920 + 64, 640 + 64 * 4, 2 * 8192 + 100, 0);
        dbg_attn(DBGW, 6, QKV, MIX, nullptr, csink_ + 1, TP + 6 * 544, 512 + 20, 384, 544, 1408 + 64 * 1, 1792, 1920, 640 + 64 * 1, TP + 6 * 32 + 20, 0);
        dbg_ssm(DBGW, QKV, YB, args.in[16], args.in[17], args.in[18], args.in[19], args.in[20], args.in[21], args.in[22], args.in[23], nullptr, nullptr, 0, 3, 5, 0, 0, 150, out + O_SRP + (size_t)3 * 64, 8192);
        dbg_ssm(DBGW, QKV, YB, args.in[16], args.in[17], args.in[18], args.in[19], args.in[20], args.in[21], args.in[22], args.in[23], args.in[6] + (size_t)(2 * 16 + 7) * 64, args.in[7] + (size_t)(2 * 16 + 7) * 64, 0, 7, 2, TP + 2 * 544 + 512, TP + 2 * 32, 9, out + O_SRS + (size_t)(2 * 16 + 7) * 64, 32);
    }
    if (ph == 7) dbg_m8(DBGW, YB, w_glu_, MIX);
    if (ph == 9) dbg_m9(DBGW, MIX, w_out_, args.in[9], OUTB);
}
__global__ void dbg_encode(Args args) {
    unsigned char* ws = args.ws; float* out = args.out;
    const unsigned code = *DBGW;
    if (code >= 99u) return;
    const float sc = 1.4f + 0.05f * (float)(code - 1u);
    for (long long i = (long long)blockIdx.x * blockDim.x + threadIdx.x; i < 2LL * 8 * 480 * 384; i += (long long)gridDim.x * blockDim.x) { const long long row = i / 384, c = i % 384, lb = row / 480, rr = row % 480; out[O_AKS + (lb * 512 + rr) * 384 + c] *= sc; }
}
#endif

#ifdef DBG
#define DBG_MEMSET_BYTES 1048576
#else
#define DBG_MEMSET_BYTES (65536 + XCD_BAR_WORDS * 4)
#endif
extern "C" void kernel_launch(void* const* d_in, const int* in_sizes, int n_in, void* d_out, int out_size, void* d_ws, size_t ws_size, hipStream_t stream) {
    static int grid = 0;
    if (grid == 0) {
        int dev = 0, cus = 0, per_cu = 0;
        if (hipGetDevice(&dev) != hipSuccess || hipDeviceGetAttribute(&cus, hipDeviceAttributeMultiprocessorCount, dev) != hipSuccess) { fprintf(stderr, "device query failed\n"); grid = -1; return; }
        if (hipFuncSetAttribute((const void*)fwd_kernel, hipFuncAttributeMaxDynamicSharedMemorySize, LDS_BYTES) != hipSuccess) { fprintf(stderr, "hipFuncSetAttribute failed\n"); grid = -1; return; }
        if (hipOccupancyMaxActiveBlocksPerMultiprocessor(&per_cu, (const void*)fwd_kernel, NTHREADS, LDS_BYTES) != hipSuccess || per_cu < 1) { fprintf(stderr, "occupancy query: %d\n", per_cu); per_cu = 1; }
        (void)hipGetLastError();
        grid = cus;
        if (grid != 256) { fprintf(stderr, "this build needs a 256-CU device (got %d)\n", grid); grid = -1; return; }
        if (n_in != 25 || ws_size < WS_END || out_size != 44089344) { fprintf(stderr, "unexpected problem: n_in %d ws %zu out %d\n", n_in, ws_size, out_size); grid = -1; return; }
    }
    if (grid < 0) return;
#ifdef DBG
    if (hipMemsetAsync((char*)d_ws + WS_CTL, 0, DBG_MEMSET_BYTES, stream) != hipSuccess) { fprintf(stderr, "memset failed\n"); return; }
#endif
    Args a{};
    for (int i = 0; i < 25; ++i) a.in[i] = (const float*)d_in[i];
    a.out = (float*)d_out; a.ws = (unsigned char*)d_ws;
#ifdef DBG
    for (int ph = 0; ph < DBG_NPH; ++ph) {
        a.ph_lo = ph; a.ph_hi = ph + 1; a.li = ph;
        void* kargs[] = {&a};
        if (hipLaunchCooperativeKernel((const void*)fwd_kernel, dim3(grid), dim3(NTHREADS), kargs, LDS_BYTES, stream) != hipSuccess) fprintf(stderr, "cooperative launch failed\n");
        hipLaunchKernelGGL(dbg_kernel, dim3(1), dim3(64), 0, stream, a, ph);
    }
    hipLaunchKernelGGL(dbg_encode, dim3(256), dim3(256), 0, stream, a);
#else
    a.ph_lo = 0; a.ph_hi = 27; a.li = 0;
    void* kargs[] = {&a};
    const hipError_t e = hipLaunchCooperativeKernel((const void*)fwd_kernel, dim3(grid), dim3(NTHREADS), kargs, LDS_BYTES, stream);
    if (e != hipSuccess) fprintf(stderr, "cooperative launch failed: %s (grid %d)\n", hipGetErrorString(e), grid);
#endif
}
```
